# Optimizing an MI355X kernel written in HIP

```python
import math
import jax, jax.numpy as jnp
from jax import lax
import numpy as np

D_MODEL = 2048
BATCH = 16
SEQ = 2048
DEPTH = 4
DEC_BATCH = 2
DEC_SEQ = 16384
PAST_LEN = 128

HEAD_DIM = 128
CHUNK = 128
Q_BLOCK = 128
A_GROUPS = D_MODEL // (2 * HEAD_DIM)
A_WIDTH = A_GROUPS * HEAD_DIM
B_HEADS = D_MODEL // (2 * HEAD_DIM)
B_QK_DIM = HEAD_DIM // 2
B_V_DIM = HEAD_DIM
B_QK_WIDTH = 2 * B_HEADS * B_QK_DIM
B_WIDTH = B_HEADS * B_V_DIM
AB_IN = 2 * A_WIDTH + 2 * B_QK_WIDTH + B_WIDTH
AB_OUT = A_WIDTH + B_WIDTH
C_HEADS = D_MODEL // HEAD_DIM
C_KV_HEADS = 4
C_GROUP = C_HEADS // C_KV_HEADS
C_WINDOW = 128
C_IN = (C_HEADS + 2 * C_KV_HEADS) * HEAD_DIM
C_OUT = C_HEADS * HEAD_DIM
D_FF = 4 * D_MODEL
ROPE_THETA = 500000.0
ROPE_FRACTION = 4
N_AB_LAYERS = (DEPTH + 1) // 2
N_C_LAYERS = DEPTH // 2
EPS = 1e-6

kernel_name = 'hybrid_gmlp_diffattn_swa_encoder'


def rms_norm(x, g):
    xf = x.astype(jnp.float32)
    y = xf * lax.rsqrt(jnp.mean(xf * xf, axis=-1, keepdims=True) + EPS)
    return (y * g.astype(jnp.float32)).astype(x.dtype)


def partial_rope(x, rot_dim):
    S = x.shape[1]
    half = rot_dim // 2
    inv = ROPE_THETA ** (-jnp.arange(half, dtype=jnp.float32) / half)
    ang = jnp.arange(S, dtype=jnp.float32)[:, None] * inv[None, :]
    cos = jnp.cos(ang)[None, :, None, :].astype(x.dtype)
    sin = jnp.sin(ang)[None, :, None, :].astype(x.dtype)
    x1, x2, rest = x[..., :half], x[..., half:rot_dim], x[..., rot_dim:]
    return jnp.concatenate([x1 * cos - x2 * sin, x2 * cos + x1 * sin, rest], axis=-1)


def chunked_gmlp(u, v, vnorm_g, ws, bs):
    B, S, G, C = v.shape
    u = jax.nn.gelu(u)
    v = rms_norm(jax.nn.gelu(v), vnorm_g)
    vc = v.reshape(B, S // CHUNK, CHUNK, G, C)
    mixed = jnp.einsum('gpq,bnqgc->bnpgc', ws, vc) + bs.T[:, :, None]
    return (u * mixed.reshape(B, S, G, C)).reshape(B, S, G * C)


def diff_attention(q, k, v, lam, lam_init, subnorm_g):
    B, S, _, H, dk = q.shape
    dv = v.shape[-1]
    nq = S // Q_BLOCK
    qb = q.reshape(B, nq, Q_BLOCK, 2, H, dk).transpose(1, 0, 2, 3, 4, 5)
    scale = dk ** -0.5

    def block(qblk):
        s = jnp.einsum('bqihd,bkihd->bihqk', qblk, k).astype(jnp.float32) * scale
        p = jax.nn.softmax(s, axis=-1)
        a = p[:, 0] - lam * p[:, 1]
        return jnp.einsum('bhqk,bkhd->bqhd', a.astype(v.dtype), v)

    o = lax.map(block, qb)
    o = o.transpose(1, 0, 2, 3, 4).reshape(B, S, H, dv)
    o = rms_norm(o, subnorm_g) * (1.0 - lam_init)
    return o.reshape(B, S, H * dv)


def window_gqa_sink(q, k, v, sink):
    B, S, HQ, d = q.shape
    nb = S // CHUNK
    qb = q.reshape(B, nb, CHUNK, C_KV_HEADS, C_GROUP, d)

    def band(t):
        tp = jnp.pad(t, ((0, 0), (CHUNK, CHUNK), (0, 0), (0, 0)))
        tp = tp.reshape(B, nb + 2, CHUNK, C_KV_HEADS, d)
        return jnp.concatenate([tp[:, :-2], tp[:, 1:-1], tp[:, 2:]], axis=2)

    kb, vb = band(k), band(v)
    s = jnp.einsum('bnqkgd,bnjkd->bnkgqj', qb, kb).astype(jnp.float32) * (d ** -0.5)
    qpos = jnp.arange(nb)[:, None, None] * CHUNK + jnp.arange(CHUNK)[None, :, None]
    kpos = (jnp.arange(nb)[:, None, None] - 1) * CHUNK + jnp.arange(3 * CHUNK)[None, None, :]
    valid = (jnp.abs(kpos - qpos) <= C_WINDOW) & (kpos >= 0) & (kpos < S)
    s = jnp.where(valid[None, :, None, None], s, -jnp.inf)
    sink_l = sink.astype(jnp.float32).reshape(C_KV_HEADS, C_GROUP)[None, None, :, :, None, None]
    m = jnp.maximum(jnp.max(s, axis=-1, keepdims=True), sink_l)
    p = jnp.exp(s - m)
    p = p / (jnp.sum(p, axis=-1, keepdims=True) + jnp.exp(sink_l - m))
    o = jnp.einsum('bnkgqj,bnjkd->bnqkgd', p.astype(v.dtype), vb)
    return o.reshape(B, S, HQ * d)


def ab_mixer(h, w_in, w_out, vnorm_g, ws, bs, lam_vecs, subnorm_g, lam_init):
    B, S, _ = h.shape
    z = h @ w_in
    u, va, qd, kd, vd = jnp.split(
        z, [A_WIDTH, 2 * A_WIDTH, 2 * A_WIDTH + B_QK_WIDTH, 2 * A_WIDTH + 2 * B_QK_WIDTH], axis=-1)
    a_out = chunked_gmlp(u.reshape(B, S, A_GROUPS, HEAD_DIM), va.reshape(B, S, A_GROUPS, HEAD_DIM),
                         vnorm_g, ws, bs)
    rot = B_QK_DIM // ROPE_FRACTION
    q = partial_rope(qd.reshape(B, S, 2 * B_HEADS, B_QK_DIM), rot).reshape(B, S, 2, B_HEADS, B_QK_DIM)
    k = partial_rope(kd.reshape(B, S, 2 * B_HEADS, B_QK_DIM), rot).reshape(B, S, 2, B_HEADS, B_QK_DIM)
    lv = lam_vecs.astype(jnp.float32)
    lam = jnp.exp(jnp.sum(lv[0] * lv[1])) - jnp.exp(jnp.sum(lv[2] * lv[3])) + lam_init
    b_out = diff_attention(q, k, vd.reshape(B, S, B_HEADS, B_V_DIM), lam, lam_init, subnorm_g)
    return jnp.concatenate([a_out, b_out], axis=-1) @ w_out


def c_mixer(h, w_in, w_out, sink):
    B, S, _ = h.shape
    z = h @ w_in
    qd, kd, vd = jnp.split(z, [C_HEADS * HEAD_DIM, (C_HEADS + C_KV_HEADS) * HEAD_DIM], axis=-1)
    rot = HEAD_DIM // ROPE_FRACTION
    q = partial_rope(qd.reshape(B, S, C_HEADS, HEAD_DIM), rot)
    k = partial_rope(kd.reshape(B, S, C_KV_HEADS, HEAD_DIM), rot)
    v = vd.reshape(B, S, C_KV_HEADS, HEAD_DIM)
    return window_gqa_sink(q, k, v, sink) @ w_out


def trunk(x, norm_mix_pre, norm_mix_post, norm_mlp_pre, norm_mlp_post,
          w_in_ab, w_out_ab, a_vnorm, a_ws, a_bs, b_lambda, b_subnorm,
          w_in_c, w_out_c, c_sink, w_up, w_down):
    for i in range(DEPTH):
        h = rms_norm(x, norm_mix_pre[i])
        j = i // 2
        if i % 2 == 0:
            lam_init = 0.8 - 0.6 * math.exp(-0.3 * i)
            h = ab_mixer(h, w_in_ab[j], w_out_ab[j], a_vnorm[j], a_ws[j], a_bs[j],
                         b_lambda[j], b_subnorm[j], lam_init)
        else:
            h = c_mixer(h, w_in_c[j], w_out_c[j], c_sink[j])
        x = x + rms_norm(h, norm_mix_post[i])
        h = rms_norm(x, norm_mlp_pre[i])
        h = jnp.square(jax.nn.relu(h @ w_up[i])) @ w_down[i]
        x = x + rms_norm(h, norm_mlp_post[i])
    return x


def setup_inputs(seed: int = 0) -> dict:
    key = jax.random.key(seed)
    ks = jax.random.split(key, 20)
    f32 = jnp.float32
    nrm = lambda k, shape, scale: jax.random.normal(k, shape, f32) * scale
    return {
        'x_prompt': nrm(ks[0], (BATCH, SEQ, D_MODEL), 1.0),
        'x_sample': nrm(ks[1], (DEC_BATCH, DEC_SEQ, D_MODEL), 1.0),
        'norm_mix_pre': 1.0 + nrm(ks[2], (DEPTH, D_MODEL), 0.05),
        'norm_mix_post': 1.0 + nrm(ks[3], (DEPTH, D_MODEL), 0.05),
        'norm_mlp_pre': 1.0 + nrm(ks[4], (DEPTH, D_MODEL), 0.05),
        'norm_mlp_post': 1.0 + nrm(ks[5], (DEPTH, D_MODEL), 0.05),
        'w_in_ab': nrm(ks[6], (N_AB_LAYERS, D_MODEL, AB_IN), D_MODEL ** -0.5),
        'w_out_ab': nrm(ks[7], (N_AB_LAYERS, AB_OUT, D_MODEL), AB_OUT ** -0.5),
        'a_vnorm': 1.0 + nrm(ks[8], (N_AB_LAYERS, A_GROUPS, HEAD_DIM), 0.05),
        'a_ws': nrm(ks[9], (N_AB_LAYERS, A_GROUPS, CHUNK, CHUNK), CHUNK ** -0.5),
        'a_bs': 1.0 + nrm(ks[10], (N_AB_LAYERS, A_GROUPS, CHUNK), 0.1),
        'b_lambda': nrm(ks[11], (N_AB_LAYERS, 4, B_QK_DIM), 0.1),
        'b_subnorm': 1.0 + nrm(ks[12], (N_AB_LAYERS, B_V_DIM), 0.05),
        'w_in_c': nrm(ks[13], (N_C_LAYERS, D_MODEL, C_IN), D_MODEL ** -0.5),
        'w_out_c': nrm(ks[14], (N_C_LAYERS, C_OUT, D_MODEL), C_OUT ** -0.5),
        'c_sink': nrm(ks[15], (N_C_LAYERS, C_HEADS), 0.5),
        'w_up': nrm(ks[16], (DEPTH, D_MODEL, D_FF), D_MODEL ** -0.5),
        'w_down': nrm(ks[17], (DEPTH, D_FF, D_MODEL), D_FF ** -0.5),
    }


def reference(x_prompt, x_sample, norm_mix_pre, norm_mix_post, norm_mlp_pre, norm_mlp_post,
              w_in_ab, w_out_ab, a_vnorm, a_ws, a_bs, b_lambda, b_subnorm,
              w_in_c, w_out_c, c_sink, w_up, w_down):
    y_prompt = trunk(x_prompt, norm_mix_pre, norm_mix_post, norm_mlp_pre, norm_mlp_post,
                     w_in_ab, w_out_ab, a_vnorm, a_ws, a_bs, b_lambda, b_subnorm,
                     w_in_c, w_out_c, c_sink, w_up, w_down)
    y_sample = trunk(x_sample, norm_mix_pre, norm_mix_post, norm_mlp_pre, norm_mlp_post,
                     w_in_ab, w_out_ab, a_vnorm, a_ws, a_bs, b_lambda, b_subnorm,
                     w_in_c, w_out_c, c_sink, w_up, w_down)
    return (y_prompt, y_sample)
```

```cpp
#include <hip/hip_runtime.h>
#include <hip/hip_bf16.h>
#include <cstdio>
#include <cstdint>
#include <cmath>
__device__ __forceinline__ int lane_id_v() { int l; asm volatile("v_mbcnt_lo_u32_b32 %0, -1, 0\n\tv_mbcnt_hi_u32_b32 %0, -1, %0" : "=v"(l)); return l; }
__device__ __forceinline__ int opaque_tid(int wv) { int l; asm volatile("v_mbcnt_lo_u32_b32 %0, -1, 0\n\tv_mbcnt_hi_u32_b32 %0, -1, %0" : "=v"(l)); return (wv << 6) | l; }
__device__ __forceinline__ int xor32_addr() { return (lane_id_v() ^ 32) << 2; }
template <int K> __device__ __forceinline__ float xor_get(float v) {
    if constexpr (K < 32) return __builtin_bit_cast(float, __builtin_amdgcn_ds_swizzle(__builtin_bit_cast(int, v), (K << 10) | 0x1f));
    else return __builtin_bit_cast(float, __builtin_amdgcn_ds_bpermute(xor32_addr(), __builtin_bit_cast(int, v)));
}
template <int K> __device__ __forceinline__ float xor_add(float v) { return v + xor_get<K>(v); }
namespace pg8 {
#define PG8_LAS __attribute__((address_space(3)))
typedef unsigned short bf16_t;
typedef short bf16x8 __attribute__((ext_vector_type(8)));
typedef float f32x4 __attribute__((ext_vector_type(4)));
typedef unsigned u32x4 __attribute__((ext_vector_type(4)));
constexpr int BM = 256, BK = 64, HALF = 128, HTB = HALF * BK * 2  , STAGE_BYTES = 8 * HTB, NXCD = 8, WGM = 4;

__host__ __device__ __forceinline__ int lds_byte(int r, int c) { const int st = (r >> 4) * 2 + (c >> 5), rr = r & 15, cc = c & 31, ob = rr * 64 + cc * 2; return st * 1024 + (ob ^ (((ob >> 9) & 1) << 5)); }
__host__ __device__ __forceinline__ void stage_rc(int b, int& R, int& C) { const int st = b / 1024, sb = b % 1024, swz = sb ^ (((sb >> 9) & 1) << 5); R = (st >> 1) * 16 + swz / 64; C = (st & 1) * 32 + (swz % 64) / 2; }
__host__ __device__ __forceinline__ int perm32(int rho) { const int n = rho >> 4, i = rho & 15; return 8 * (i >> 2) + 4 * n + (i & 3); }

struct Unit { int pm, pn; };
struct Gemm { const bf16_t* A; const bf16_t* Bt; int M, N, K; };

struct StaticOrder {
    int nM, nN, nwg, G, c, wgm;
    __host__ __device__ void init(int M, int N, int G_, int c_, int wgm_ = WGM) { nM = M / BM; nN = N / BM; nwg = nM * nN; G = G_; c = c_; wgm = wgm_; }
    __host__ __device__ bool next(int i, Unit& u) const {
        const long L = (long)i * G + c; if (L >= nwg) return false;
        int wgid = (int)L; { const int q = nwg / NXCD, r = nwg % NXCD, xcd = wgid % NXCD, off = wgid / NXCD; wgid = (xcd < r ? xcd * (q + 1) : r * (q + 1) + (xcd - r) * q) + off; }
        const int nig = wgm * nN, gid = wgid / nig, fm = gid * wgm, gsz = (nM - fm) < wgm ? (nM - fm) : wgm;
        u.pm = fm + ((wgid % nig) % gsz); u.pn = (wgid % nig) / gsz; return true;
    }
    __device__ __forceinline__ void a_ready(const Unit&) const {}
    __device__ __forceinline__ void done(const Unit&) const {}
};

__device__ __forceinline__ unsigned cvt_pk_bf16(float lo, float hi) { unsigned r; asm volatile("v_cvt_pk_bf16_f32 %0, %1, %2" : "=v"(r) : "v"(lo), "v"(hi)); return r; }
typedef float f32x2 __attribute__((ext_vector_type(2)));
__device__ __forceinline__ float gelu_tanh(float x) {
    const float t = x * (2.3022082f + 0.10294324f * x * x);
    return x * __builtin_amdgcn_rcpf(1.0f + __builtin_amdgcn_exp2f(-t));
}
template <int MODE> struct EpiAct {
    static constexpr bool PERM = true, AFTER_DRAIN = false;
    bf16_t* O; int ldc; const float* tab; int smask; const float* rs;
    __device__ __forceinline__ void operator()(const f32x4 (&acc)[2][2][4][2], const Unit& u, int wr, int wc, int fr, int fq) const {
        const int row0 = u.pm * BM + wr * 64 + fr; const int colt = u.pn * BM;
        const int col0 = colt + wc * 32 + 8 * fq;
        int mode = 0;
        if (MODE == 1) mode = 1;
        if (MODE == 2) mode = colt < 2048 ? 2 : (colt < 4096 ? 3 : 0);
        if (MODE == 3) mode = colt < 2560 ? 4 : 0;
        const bool ropeB = (mode == 3) && ((wc & 1) == 0), ropeC = (mode == 4) && (wc == 0);
        float rsv[8];
#pragma unroll
        for (int k = 0; k < 8; ++k) rsv[k] = (MODE != 0) ? rs[row0 + (k >> 2) * HALF + (k & 3) * 16] : 1.f;
        asm volatile("" ::: "memory");
#pragma unroll
        for (int ai = 0; ai < 2; ++ai)
#pragma unroll
            for (int m = 0; m < 4; ++m) {
                const int row = row0 + ai * HALF + m * 16;
                bf16_t* rowp = O + (size_t)row * ldc + col0;
                const float rsc = rsv[ai * 4 + m];
                f32x4 c0 = {1.f, 1.f, 1.f, 1.f}, c1 = c0, s0 = {0.f, 0.f, 0.f, 0.f}, s1 = s0;
                if (MODE == 2) { if (ropeB) { const float* t = tab + (size_t)(row & smask) * 16; c0 = *(const f32x4*)t; c1 = *(const f32x4*)(t + 4); s0 = *(const f32x4*)(t + 8); s1 = *(const f32x4*)(t + 12); } }
                if (MODE == 3) { if (ropeC) { const float* t = tab + (size_t)(row & smask) * 32 + (fq & 1) * 8; c0 = *(const f32x4*)t; c1 = *(const f32x4*)(t + 4); s0 = *(const f32x4*)(t + 16); s1 = *(const f32x4*)(t + 20); } }
#pragma unroll
                for (int bj = 0; bj < 2; ++bj) {
                    f32x4 v0 = acc[ai][bj][m][0], v1 = acc[ai][bj][m][1];
                    if (MODE != 0) { v0 = v0 * rsc; v1 = v1 * rsc; }
                    if (MODE == 1) {
#pragma unroll
                        for (int j = 0; j < 4; ++j) { const float a = fmaxf(v0[j], 0.f), b = fmaxf(v1[j], 0.f); v0[j] = a * a; v1[j] = b * b; }
                    }
                    if (MODE == 2) {
                        if (mode == 2) {
#pragma unroll
                            for (int j = 0; j < 4; ++j) { v0[j] = gelu_tanh(v0[j]); v1[j] = gelu_tanh(v1[j]); }
                        }
                        if (ropeB) {
                            f32x4 o0, o1;
#pragma unroll
                            for (int j = 0; j < 4; ++j) { o0[j] = xor_get<16>(v0[j]); o1[j] = xor_get<16>(v1[j]); }
                            if (fq < 2) { const float sg = fq ? 1.f : -1.f; v0 = v0 * c0 + (o0 * s0) * sg; v1 = v1 * c1 + (o1 * s1) * sg; }
                        }
                    }
                    if (MODE == 3) {
                        if (ropeC) {
                            f32x4 o0, o1;
#pragma unroll
                            for (int j = 0; j < 4; ++j) { o0[j] = xor_get<32>(v0[j]); o1[j] = xor_get<32>(v1[j]); }
                            const float sg = (fq >= 2) ? 1.f : -1.f; v0 = v0 * c0 + (o0 * s0) * sg; v1 = v1 * c1 + (o1 * s1) * sg;
                        }
                    }
                    if (MODE == 2) { if (colt >= 2048 && colt < 3072) { v0 = v0 * 0.18033688011112042f; v1 = v1 * 0.18033688011112042f; } }
                    if (MODE == 3) { if (colt < 2048) { v0 = v0 * 0.12751743082459868f; v1 = v1 * 0.12751743082459868f; } }
                    u32x4 w; w.x = cvt_pk_bf16(v0[0], v0[1]); w.y = cvt_pk_bf16(v0[2], v0[3]); w.z = cvt_pk_bf16(v1[0], v1[1]); w.w = cvt_pk_bf16(v1[2], v1[3]);
                    if (MODE == 1) __builtin_nontemporal_store(w, (u32x4*)(rowp + bj * HALF));
                    else *(u32x4*)(rowp + bj * HALF) = w;
                }

            }
    }
};

template <class Epi, class Sched, bool ALIGN_EPI = false, bool SP2 = false, int AUXA = 0>
__device__ __forceinline__ void gemm_phase(PG8_LAS unsigned char* lds, const Gemm g, const Sched& S, const Epi& E, const int wv) {
    const int tid = opaque_tid(wv), wid = wv, lane = tid & 63, wr = wid >> 2, wc = wid & 3, fr = lane & 15, fq = lane >> 4;
    const int K = g.K, nt = K / BK;
    unsigned voffA[2], voffB[2];
#pragma unroll
    for (int i = 0; i < 2; ++i) { int R, C; stage_rc(tid * 16 + i * 8192, R, C); const int Rb = Epi::PERM ? ((R & ~31) + perm32(R & 31)) : R;
        voffA[i] = (unsigned)(R * K + C) * 2u; voffB[i] = (unsigned)(Rb * K + C) * 2u; }
    const size_t kstep = (size_t)(BK * 2);
    const size_t hstep = (size_t)HALF * K * 2;
    const size_t tstep = 2 * hstep;
    const unsigned ldsw = (unsigned)wid * 1024u;
    const int aoff = lds_byte(wr * 64 + fr, fq * 8), boff = lds_byte(wc * 32 + fr, fq * 8);
#define PG8_SA(b, h) (((b) * 2 + (h)) * HTB)
#define PG8_SB(b, h) ((4 + (b) * 2 + (h)) * HTB)
#define PG8_STAGE(bufoff, gbase, voff) do { _Pragma("unroll") for (int _i = 0; _i < 2; ++_i) \
        __builtin_amdgcn_global_load_lds((const unsigned*)((const char*)(gbase) + (voff)[_i]), (PG8_LAS unsigned*)(lds + (bufoff) + ldsw + _i * 8192), 16, 0, 0); } while (0)
#define PG8_STAGEA(bufoff, gbase, voff) do { _Pragma("unroll") for (int _i = 0; _i < 2; ++_i) \
        __builtin_amdgcn_global_load_lds((const unsigned*)((const char*)(gbase) + (voff)[_i]), (PG8_LAS unsigned*)(lds + (bufoff) + ldsw + _i * 8192), 16, 0, AUXA); } while (0)
#define PG8_LDA(dst, b, h) do { _Pragma("unroll") for (int m = 0; m < 4; ++m) _Pragma("unroll") for (int k = 0; k < 2; ++k) dst[m][k] = *(const PG8_LAS bf16x8*)(lds + PG8_SA(b, h) + aoff + m * 2048 + k * 1024); } while (0)
#define PG8_LDB(dst, b, h) do { _Pragma("unroll") for (int n = 0; n < 2; ++n) _Pragma("unroll") for (int k = 0; k < 2; ++k) dst[n][k] = *(const PG8_LAS bf16x8*)(lds + PG8_SB(b, h) + boff + n * 2048 + k * 1024); } while (0)
#define PG8_MMA(ai, bj, At, Bt) do { __builtin_amdgcn_s_setprio(1); _Pragma("unroll") for (int m = 0; m < 4; ++m) _Pragma("unroll") for (int n = 0; n < 2; ++n) _Pragma("unroll") for (int k = 0; k < 2; ++k) \
        acc[ai][bj][m][n] = __builtin_amdgcn_mfma_f32_16x16x32_bf16(Bt[n][k], At[m][k], acc[ai][bj][m][n], 0, 0, 0); __builtin_amdgcn_s_setprio(0); } while (0)
#define PG8_WAIT_V(n) asm volatile("s_waitcnt vmcnt(" #n ")" ::: "memory")
#define PG8_WAIT_L(n) asm volatile("s_waitcnt lgkmcnt(" #n ")" ::: "memory")
#define PG8_BAR __builtin_amdgcn_s_barrier()
#define PG8_SCHED __builtin_amdgcn_sched_barrier(0)
    Unit cur, nxt; int ui = 0;
    if (!S.next(0, cur)) return;
    f32x4 acc[2][2][4][2];
#pragma unroll
    for (int a = 0; a < 2; ++a)
#pragma unroll
        for (int b = 0; b < 2; ++b)
#pragma unroll
            for (int m = 0; m < 4; ++m)
#pragma unroll
                for (int n = 0; n < 2; ++n) acc[a][b][m][n] = (f32x4){0.f, 0.f, 0.f, 0.f};
    bf16x8 At[4][2], B0[2][2], B1[2][2];
    const char* cA = (const char*)g.A + (size_t)cur.pm * tstep; const char* cB = (const char*)g.Bt + (size_t)cur.pn * tstep;
    S.a_ready(cur);
    if constexpr (SP2) {
        PG8_STAGE(PG8_SB(0, 0), cB, voffB); PG8_STAGE(PG8_SB(0, 1), cB + hstep, voffB); PG8_STAGEA(PG8_SA(0, 0), cA, voffA); PG8_STAGEA(PG8_SA(0, 1), cA + hstep, voffA);
        if (wr == 1) PG8_BAR;
        PG8_WAIT_V(2); PG8_BAR;
        PG8_STAGE(PG8_SB(1, 0), cB + kstep, voffB); PG8_STAGEA(PG8_SA(1, 0), cA + kstep, voffA); PG8_STAGE(PG8_SB(1, 1), cB + hstep + kstep, voffB);
        PG8_WAIT_V(6); PG8_BAR;
    } else {
        PG8_STAGE(PG8_SB(0, 0), cB, voffB); PG8_STAGEA(PG8_SA(0, 0), cA, voffA); PG8_STAGE(PG8_SB(0, 1), cB + hstep, voffB); PG8_STAGEA(PG8_SA(0, 1), cA + hstep, voffA);
        if (wr == 1) PG8_BAR;
        PG8_WAIT_V(4); PG8_BAR;
        PG8_STAGE(PG8_SB(1, 0), cB + kstep, voffB); PG8_STAGEA(PG8_SA(1, 0), cA + kstep, voffA); PG8_STAGE(PG8_SB(1, 1), cB + hstep + kstep, voffB);
        PG8_WAIT_V(6); PG8_BAR;
    }
    for (;;) {
        const bool has_next = S.next(ui + 1, nxt);
        const char* nA = has_next ? (const char*)g.A + (size_t)nxt.pm * tstep : cA; const char* nB = has_next ? (const char*)g.Bt + (size_t)nxt.pn * tstep : cB;
        for (int t = 0; t < nt; t += 2) {
            const bool last = (t == nt - 2);
            const char* a1 = cA + (size_t)(t + 1) * kstep;
            const char* a2 = last ? nA : cA + (size_t)(t + 2) * kstep; const char* b2 = last ? nB : cB + (size_t)(t + 2) * kstep;
            const char* a3 = a2 + kstep; const char* b3 = b2 + kstep;
            if (last && has_next) S.a_ready(nxt);
            if constexpr (SP2) {
            PG8_LDB(B0, 0, 0); PG8_LDB(B1, 0, 1); PG8_SCHED; PG8_LDA(At, 0, 0); PG8_STAGEA(PG8_SA(1, 1), a1 + hstep, voffA);
            PG8_WAIT_V(8); PG8_WAIT_L(0); PG8_BAR; PG8_MMA(0, 0, At, B0); PG8_MMA(0, 1, At, B1); PG8_BAR; PG8_SCHED;
            PG8_LDA(At, 0, 1); PG8_STAGE(PG8_SB(0, 0), b2, voffB); PG8_STAGE(PG8_SB(0, 1), b2 + hstep, voffB); PG8_STAGEA(PG8_SA(0, 0), a2, voffA);
            PG8_WAIT_V(8); PG8_WAIT_L(0); PG8_BAR; PG8_MMA(1, 0, At, B0); PG8_MMA(1, 1, At, B1); PG8_BAR; PG8_SCHED;
            PG8_LDB(B0, 1, 0); PG8_LDB(B1, 1, 1); PG8_SCHED; PG8_LDA(At, 1, 0); PG8_STAGEA(PG8_SA(0, 1), a2 + hstep, voffA);
            PG8_WAIT_V(8); PG8_WAIT_L(0); PG8_BAR; PG8_MMA(0, 0, At, B0); PG8_MMA(0, 1, At, B1); PG8_BAR; PG8_SCHED;
            PG8_LDA(At, 1, 1); PG8_STAGE(PG8_SB(1, 0), b3, voffB); PG8_STAGE(PG8_SB(1, 1), b3 + hstep, voffB); PG8_STAGEA(PG8_SA(1, 0), a3, voffA);
            PG8_WAIT_V(8); PG8_WAIT_L(0); PG8_BAR; PG8_MMA(1, 0, At, B0); PG8_MMA(1, 1, At, B1); PG8_BAR; PG8_SCHED;
            } else {
            PG8_LDB(B0, 0, 0); PG8_SCHED; PG8_LDA(At, 0, 0); PG8_STAGEA(PG8_SA(1, 1), a1 + hstep, voffA);
            PG8_WAIT_L(8); PG8_BAR; PG8_WAIT_L(0); PG8_MMA(0, 0, At, B0); PG8_BAR; PG8_SCHED;
            PG8_LDB(B1, 0, 1); PG8_STAGE(PG8_SB(0, 0), b2, voffB);
            PG8_BAR; PG8_WAIT_L(0); PG8_MMA(0, 1, At, B1); PG8_BAR;
            PG8_LDA(At, 0, 1); PG8_STAGEA(PG8_SA(0, 0), a2, voffA);
            PG8_BAR; PG8_WAIT_L(0); PG8_MMA(1, 0, At, B0); PG8_BAR; PG8_SCHED;
            PG8_STAGE(PG8_SB(0, 1), b2 + hstep, voffB);
            PG8_WAIT_V(6); PG8_BAR; PG8_MMA(1, 1, At, B1); PG8_BAR;
            PG8_LDB(B0, 1, 0); PG8_SCHED; PG8_LDA(At, 1, 0); PG8_STAGEA(PG8_SA(0, 1), a2 + hstep, voffA);
            PG8_WAIT_L(8); PG8_BAR; PG8_WAIT_L(0); PG8_MMA(0, 0, At, B0); PG8_BAR; PG8_SCHED;
            PG8_LDB(B1, 1, 1); PG8_STAGE(PG8_SB(1, 0), b3, voffB);
            PG8_BAR; PG8_WAIT_L(0); PG8_MMA(0, 1, At, B1); PG8_BAR;
            PG8_LDA(At, 1, 1); PG8_STAGEA(PG8_SA(1, 0), a3, voffA);
            PG8_BAR; PG8_WAIT_L(0); PG8_MMA(1, 0, At, B0); PG8_BAR; PG8_SCHED;
            PG8_STAGE(PG8_SB(1, 1), b3 + hstep, voffB);
            PG8_WAIT_V(6); PG8_BAR; PG8_MMA(1, 1, At, B1); PG8_BAR;
            }
        }
        if constexpr (ALIGN_EPI) { if (wr == 0) PG8_BAR; }
        if constexpr (!Epi::AFTER_DRAIN) { E(acc, cur, wr, wc, fr, fq); S.done(cur); }
        if (!has_next) break;
#pragma unroll
        for (int a = 0; a < 2; ++a)
#pragma unroll
            for (int b = 0; b < 2; ++b)
#pragma unroll
                for (int m = 0; m < 4; ++m)
#pragma unroll
                    for (int n = 0; n < 2; ++n) acc[a][b][m][n] = (f32x4){0.f, 0.f, 0.f, 0.f};
        cur = nxt; cA = nA; cB = nB; ++ui;
        if constexpr (ALIGN_EPI) { if (wr == 1) PG8_BAR; }
    }
    PG8_WAIT_V(0);
    if constexpr (!ALIGN_EPI) { if (wr == 0) PG8_BAR; }
    PG8_BAR;
    if constexpr (Epi::AFTER_DRAIN) { E.fused(acc, cur, wr, wc, fr, fq, lds, wid, lane); S.done(cur); }
#undef PG8_SA
#undef PG8_SB
#undef PG8_STAGE
#undef PG8_STAGEA
#undef PG8_LDA
#undef PG8_LDB
#undef PG8_MMA
#undef PG8_WAIT_V
#undef PG8_WAIT_L
#undef PG8_BAR
#undef PG8_SCHED
}
}
namespace att {
using bf16 = unsigned short;
using bf16x8 = __attribute__((ext_vector_type(8))) short;
using s16x4  = __attribute__((ext_vector_type(4))) short;
using f32x16 = __attribute__((ext_vector_type(16))) float;
using u32x4  = __attribute__((ext_vector_type(4))) unsigned;
constexpr int KVBLK = 64;
constexpr size_t SHM_V = KVBLK * 128 * 2, SHM_K = KVBLK * 128 * 2;
constexpr size_t SHM_SCR = 2 * SHM_V + 2 * SHM_K;
constexpr size_t SHM_ATTN = SHM_SCR + 8 * 64 * 4;
constexpr float THR = 8.f;
#define KSWZ(row, colB) ((row) * 256 + ((colB) ^ (((row) & 7) << 4)))
#define SBAR() __builtin_amdgcn_sched_barrier(0)
__device__ __forceinline__ int crow(int r, int hi) { return (r & 3) + 8 * (r >> 2) + 4 * hi; }
__device__ __forceinline__ unsigned cvtpk(float lo, float hi) { unsigned r; asm volatile("v_cvt_pk_bf16_f32 %0, %1, %2" : "=v"(r) : "v"(lo), "v"(hi)); return r; }
__device__ __forceinline__ float max3f(float a, float b, float c) { return __builtin_fmaxf(__builtin_fmaxf(a, b), c); }
__device__ __forceinline__ float bf2f(unsigned short b) { return __uint_as_float(((unsigned)b) << 16); }

constexpr float THRL = 8.f;
template <bool MASK, bool FIRST>
__device__ __forceinline__ void partialSM(f32x16& p0, f32x16& p1, float& mhat, f32x16& negm, float& alpha, int mb, int hi) {
  if (MASK) {
#pragma unroll
    for (int r = 0; r < 16; ++r) { const int d = mb + crow(r, hi) + 128;
      if ((unsigned)d > 256u) p0[r] = -INFINITY; if ((unsigned)(d + 32) > 256u) p1[r] = -INFINITY; }
  }
  float pmax;
  { float a = max3f(p0[0], p0[1], p1[0]), b = max3f(p0[2], p0[3], p1[1]); a = max3f(a, p1[2], p1[3]);
#pragma unroll
    for (int r = 4; r < 16; r += 4) { a = max3f(a, p0[r], p0[r + 1]); b = max3f(b, p0[r + 2], p0[r + 3]); a = max3f(a, p1[r], p1[r + 1]); b = max3f(b, p1[r + 2], p1[r + 3]); }
    pmax = fmaxf(a, b); }
  { float pmax2 = pmax; asm volatile("" : "+v"(pmax2));
    auto rr = __builtin_amdgcn_permlane32_swap(__float_as_uint(pmax), __float_as_uint(pmax2), false, false);
    pmax = fmaxf(__uint_as_float(rr[0]), __uint_as_float(rr[1])); }
  alpha = 1.f;
  if (FIRST || !__builtin_expect(__all(pmax <= THRL), 1)) {
    const float dl = FIRST ? pmax : fmaxf(pmax, 0.f);
    mhat += dl;
#pragma unroll
    for (int r = 0; r < 16; ++r) { p0[r] -= dl; p1[r] -= dl; }
#pragma unroll
    for (int r = 0; r < 16; ++r) negm[r] = -mhat;
    asm volatile("" : "+v"(negm));
    alpha = __builtin_amdgcn_exp2f(-dl);
  }
#pragma unroll
  for (int r = 0; r < 16; ++r) p0[r] = __builtin_amdgcn_exp2f(p0[r]);
}
__device__ __forceinline__ void finishSM(f32x16& p0, f32x16& p1, float alpha, float& l_reg, bf16x8& pa0, bf16x8& pa1, bf16x8& pa2, bf16x8& pa3) {
#pragma unroll
  for (int r = 0; r < 16; ++r) p1[r] = __builtin_amdgcn_exp2f(p1[r]);
  float ps = 0;
#pragma unroll
  for (int r = 0; r < 16; ++r) ps += p0[r];
#pragma unroll
  for (int r = 0; r < 16; ++r) ps += p1[r];
  { float ps2 = ps; asm volatile("" : "+v"(ps2));
    auto rr = __builtin_amdgcn_permlane32_swap(__float_as_uint(ps), __float_as_uint(ps2), false, false);
    ps = __uint_as_float(rr[0]) + __uint_as_float(rr[1]); }
  l_reg = l_reg * alpha + ps;
#define PK4(P, BASE, OUT) do { unsigned a0 = cvtpk(P[BASE + 0], P[BASE + 1]), a1 = cvtpk(P[BASE + 2], P[BASE + 3]);   \
    unsigned b0 = cvtpk(P[BASE + 4], P[BASE + 5]), b1 = cvtpk(P[BASE + 6], P[BASE + 7]);                              \
    auto r0 = __builtin_amdgcn_permlane32_swap(a0, b0, false, false); auto r1 = __builtin_amdgcn_permlane32_swap(a1, b1, false, false); \
    u32x4 w = {r0[0], r1[0], r0[1], r1[1]}; OUT = *reinterpret_cast<bf16x8*>(&w); } while (0)
  PK4(p0, 0, pa0); PK4(p0, 8, pa1); PK4(p1, 0, pa2); PK4(p1, 8, pa3);
#undef PK4
}
template <int ND0>
__device__ __forceinline__ void qkt(f32x16& p0, f32x16& p1, const char* Ks, const bf16x8* qr, const f32x16& negm, int r32, int hi, int kb0) {
#pragma unroll
  for (int d0 = 0; d0 < ND0; ++d0) { const int cb = ((kb0 + d0) * 16 + hi * 8) * 2;
    bf16x8 b0 = *reinterpret_cast<const bf16x8*>(Ks + KSWZ(r32, cb));
    bf16x8 b1 = *reinterpret_cast<const bf16x8*>(Ks + KSWZ(32 + r32, cb));
    if (d0 == 0) { p0 = __builtin_amdgcn_mfma_f32_32x32x16_bf16(b0, qr[0], negm, 0, 0, 0); p1 = __builtin_amdgcn_mfma_f32_32x32x16_bf16(b1, qr[0], negm, 0, 0, 0); }
    else { p0 = __builtin_amdgcn_mfma_f32_32x32x16_bf16(b0, qr[d0], p0, 0, 0, 0); p1 = __builtin_amdgcn_mfma_f32_32x32x16_bf16(b1, qr[d0], p1, 0, 0, 0); } }
}
__device__ __forceinline__ int v_st(int k, int c) { const int kk = (k & ~0xC) | ((k & 4) << 1) | ((k & 8) >> 1); return ((kk >> 3) * 4 + (c >> 5)) * 512 + ((kk & 7) * 32 + (c & 31)) * 2; }
__device__ __forceinline__ int v_rd_base(int lane) { return ((lane & 3) << 3) | (((lane >> 2) & 3) << 6) | (((lane >> 4) & 1) << 5) | (((lane >> 5) & 1) << 8); }
constexpr int v_rd_off(int d0, int ks, int half) { return d0 * 512 + ks * 4096 + half * 2048; }
template <int OFF> __device__ __forceinline__ s16x4 tr_read(int vb) {
  s16x4 r; asm volatile("ds_read_b64_tr_b16 %0, %1 offset:%2" : "=&v"(r) : "v"(vb), "i"(OFF) : "memory"); return r;
}
template <int D0> __device__ __forceinline__ void pv_one(f32x16& od, int vb, bf16x8 pa0, bf16x8 pa1, bf16x8 pa2, bf16x8 pa3) {
  const s16x4 l0 = tr_read<v_rd_off(D0, 0, 0)>(vb), h0 = tr_read<v_rd_off(D0, 0, 1)>(vb), l1 = tr_read<v_rd_off(D0, 1, 0)>(vb), h1 = tr_read<v_rd_off(D0, 1, 1)>(vb);
  const s16x4 l2 = tr_read<v_rd_off(D0, 2, 0)>(vb), h2 = tr_read<v_rd_off(D0, 2, 1)>(vb), l3 = tr_read<v_rd_off(D0, 3, 0)>(vb), h3 = tr_read<v_rd_off(D0, 3, 1)>(vb);
  asm volatile("s_waitcnt lgkmcnt(0)" ::: "memory"); SBAR();
#define PK(L, H) (bf16x8){L[0], L[1], L[2], L[3], H[0], H[1], H[2], H[3]}
  od = __builtin_amdgcn_mfma_f32_32x32x16_bf16(pa0, PK(l0, h0), od, 0, 0, 0);
  od = __builtin_amdgcn_mfma_f32_32x32x16_bf16(pa1, PK(l1, h1), od, 0, 0, 0);
  od = __builtin_amdgcn_mfma_f32_32x32x16_bf16(pa2, PK(l2, h2), od, 0, 0, 0);
  od = __builtin_amdgcn_mfma_f32_32x32x16_bf16(pa3, PK(l3, h3), od, 0, 0, 0);
#undef PK
}
__device__ __forceinline__ void pv_d0(f32x16* o, int vb, bf16x8 pa0, bf16x8 pa1, bf16x8 pa2, bf16x8 pa3) {
  pv_one<0>(o[0], vb, pa0, pa1, pa2, pa3); pv_one<1>(o[1], vb, pa0, pa1, pa2, pa3); pv_one<2>(o[2], vb, pa0, pa1, pa2, pa3); pv_one<3>(o[3], vb, pa0, pa1, pa2, pa3);
}

template <int ND0, bool MASK, int SDEPTH, bool FIRSTREF, bool SKIP>
__device__ __forceinline__ void attn_core(const bf16x8* qr, const bf16* __restrict__ Kt, const bf16* __restrict__ Vt, const long ld, const int NT, const int mb0, const int kb0,
                                          float mhat, float& l_reg, f32x16 (&o)[4], char* lds, const int wv) {
  const int tid = opaque_tid(wv), wid = tid >> 6, lane = tid & 63, r32 = lane & 31, hi = lane >> 5;
  char* V_lds = lds; char* K_lds = lds + 2 * SHM_V;
  float* al_l = (float*)(lds + SHM_SCR) + wid * 64 + 32;
  const int sr = tid >> 4, sc = (tid & 15) * 8, vst0 = v_st(sr, sc), vst1 = v_st(32 + sr, sc);
  const int vb0 = (int)(uintptr_t)V_lds + v_rd_base(lane);
  const int wrel = (MASK && SKIP) ? __builtin_amdgcn_readfirstlane(mb0 + r32) : 0;
#define ACT(t) (!(MASK && SKIP) || (unsigned)(wrel + 64 * (t) + 191) <= 350u)
  struct { bf16x8 vs0, vs1, ks0, ks1; } sr_[SDEPTH];
#define SLOAD(i, k0) do { sr_[i].vs0 = *(const bf16x8*)(Vt + (long)(k0) * ld); sr_[i].vs1 = *(const bf16x8*)(Vt + (long)((k0) + 32) * ld); \
    sr_[i].ks0 = *(const bf16x8*)(Kt + (long)(k0) * ld); sr_[i].ks1 = *(const bf16x8*)(Kt + (long)((k0) + 32) * ld); } while (0)
#define SWRITE(b, i) do { *(bf16x8*)(V_lds + (b) * SHM_V + vst0) = sr_[i].vs0; *(bf16x8*)(V_lds + (b) * SHM_V + vst1) = sr_[i].vs1; const int kc = sc * 2; \
    *(bf16x8*)(K_lds + (b) * SHM_K + KSWZ(sr, kc)) = sr_[i].ks0; *(bf16x8*)(K_lds + (b) * SHM_K + KSWZ(32 + sr, kc)) = sr_[i].ks1; } while (0)
#define SWAIT() do { if constexpr (SDEPTH == 2) asm volatile("s_waitcnt vmcnt(4)" ::: "memory"); else asm volatile("s_waitcnt vmcnt(0)" ::: "memory"); } while (0)
#define RESC(a) do { if (__any((a) < 1.f)) { if (hi == 0) al_l[r32] = (a); asm volatile("s_waitcnt lgkmcnt(0)" ::: "memory"); \
    _Pragma("unroll") for (int d = 0; d < 4; ++d) _Pragma("unroll") for (int r = 0; r < 16; ++r) o[d][r] *= al_l[crow(r, hi)]; } } while (0)
  f32x16 pA0, pA1, pB0, pB1; float alA = 1.f, alB = 1.f; bf16x8 pa0, pa1, pa2, pa3;
  f32x16 negm;
#pragma unroll
  for (int r = 0; r < 16; ++r) negm[r] = -mhat;
  asm volatile("" : "+v"(negm));
  constexpr int SE = 0, SO = SDEPTH - 1;
  bool aA = ACT(0), aB = false;
  SLOAD(SE, 0); asm volatile("s_waitcnt vmcnt(0)" ::: "memory"); SWRITE(0, SE); __syncthreads();
  if (aA) { qkt<ND0>(pA0, pA1, K_lds, qr, negm, r32, hi, kb0); partialSM<MASK, FIRSTREF>(pA0, pA1, mhat, negm, alA, mb0, hi); }
  SLOAD(SO, KVBLK); if constexpr (SDEPTH == 2) { if (2 < NT) SLOAD(SE, 2 * KVBLK); }
  SWAIT(); SWRITE(1, SO); __syncthreads();
  for (int j = 1; j + 1 < NT; j += 2) {
    aB = ACT(j);
    SBAR(); if (aB) qkt<ND0>(pB0, pB1, K_lds + SHM_K, qr, negm, r32, hi, kb0);
    if (aA) finishSM(pA0, pA1, alA, l_reg, pa0, pa1, pa2, pa3); SBAR();
    SLOAD(SO, (j + SDEPTH) * KVBLK); SBAR();
    if (aA) pv_d0(o, vb0, pa0, pa1, pa2, pa3);
    alB = 1.f; if (aB) partialSM<MASK, false>(pB0, pB1, mhat, negm, alB, mb0 + j * KVBLK, hi);
    __syncthreads(); SWAIT(); SWRITE(0, SE);
    RESC(alB); __syncthreads();
    aA = ACT(j + 1);
    SBAR(); if (aA) qkt<ND0>(pA0, pA1, K_lds, qr, negm, r32, hi, kb0);
    if (aB) finishSM(pB0, pB1, alB, l_reg, pa0, pa1, pa2, pa3); SBAR();
    if (SDEPTH == 1 || j + 3 < NT) SLOAD(SE, (j + 1 + SDEPTH) * KVBLK); SBAR();
    if (aB) pv_d0(o, vb0 + (int)SHM_V, pa0, pa1, pa2, pa3);
    alA = 1.f; if (aA) partialSM<MASK, false>(pA0, pA1, mhat, negm, alA, mb0 + (j + 1) * KVBLK, hi);
    __syncthreads(); SWAIT(); SWRITE(1, SO);
    RESC(alA); __syncthreads();
  }
  aB = ACT(NT - 1);
  SBAR(); if (aB) qkt<ND0>(pB0, pB1, K_lds + SHM_K, qr, negm, r32, hi, kb0);
  if (aA) finishSM(pA0, pA1, alA, l_reg, pa0, pa1, pa2, pa3); SBAR();
  if (aA) pv_d0(o, vb0, pa0, pa1, pa2, pa3);
  alB = 1.f; if (aB) partialSM<MASK, false>(pB0, pB1, mhat, negm, alB, mb0 + (NT - 1) * KVBLK, hi);
  __syncthreads(); RESC(alB);
  if (aB) { finishSM(pB0, pB1, alB, l_reg, pa0, pa1, pa2, pa3); SBAR();
    pv_d0(o, vb0 + (int)SHM_V, pa0, pa1, pa2, pa3); }
#undef ACT
#undef SLOAD
#undef SWRITE
#undef SWAIT
#undef RESC
}

constexpr size_t RING_SCR = 6 * 16384;
template <int ND0, bool MASK, bool FIRSTREF>
__device__ __forceinline__ void attn_core_ring(const bf16x8* qr, const bf16* __restrict__ Kt, const bf16* __restrict__ Vt, const long ld, const int NT, const int mb0, const int kb0,
                                               float mhat, float& l_reg, f32x16 (&o)[4], char* lds, const int wv) {
  const int tid = opaque_tid(wv), wid = tid >> 6, lane = tid & 63, r32 = lane & 31, hi = lane >> 5;
  char* V_lds = lds; char* K_lds = lds + 3 * 16384;
  float* al_l = (float*)(lds + RING_SCR) + wid * 64 + 32;
  const int sr = tid >> 4, sc = (tid & 15) * 8, vst0 = v_st(sr, sc), vst1 = v_st(32 + sr, sc);
  const int vb0 = (int)(uintptr_t)V_lds + v_rd_base(lane);
  bf16x8 svs0, svs1, sks0, sks1;
#define SLOAD(k0) do { svs0 = *(const bf16x8*)(Vt + (long)(k0) * ld); svs1 = *(const bf16x8*)(Vt + (long)((k0) + 32) * ld); \
    sks0 = *(const bf16x8*)(Kt + (long)(k0) * ld); sks1 = *(const bf16x8*)(Kt + (long)((k0) + 32) * ld); } while (0)
#define SWRITE(off) do { *(bf16x8*)(V_lds + (off) + vst0) = svs0; *(bf16x8*)(V_lds + (off) + vst1) = svs1; const int kc = sc * 2; \
    *(bf16x8*)(K_lds + (off) + KSWZ(sr, kc)) = sks0; *(bf16x8*)(K_lds + (off) + KSWZ(32 + sr, kc)) = sks1; } while (0)
#define RESC(a) do { if (__any((a) < 1.f)) { if (hi == 0) al_l[r32] = (a); asm volatile("s_waitcnt lgkmcnt(0)" ::: "memory"); \
    _Pragma("unroll") for (int d = 0; d < 4; ++d) _Pragma("unroll") for (int r = 0; r < 16; ++r) o[d][r] *= al_l[crow(r, hi)]; } } while (0)
#define LBAR() asm volatile("s_waitcnt lgkmcnt(0)\n\ts_barrier" ::: "memory")
#define ROT() do { const int t_ = prv; prv = cur; cur = nxt; nxt = t_; } while (0)
  f32x16 pA0, pA1, pB0, pB1; float alA, alB; bf16x8 pa0, pa1, pa2, pa3;
  f32x16 negm;
#pragma unroll
  for (int r = 0; r < 16; ++r) negm[r] = -mhat;
  asm volatile("" : "+v"(negm));
  int prv = 2 * 16384, cur = 0, nxt = 16384;
  SLOAD(0); asm volatile("s_waitcnt vmcnt(0)" ::: "memory"); SWRITE(0); SLOAD(KVBLK);
  __syncthreads();
  qkt<ND0>(pA0, pA1, K_lds + cur, qr, negm, r32, hi, kb0);
  SWRITE(nxt); if (2 < NT) SLOAD(2 * KVBLK);
  partialSM<MASK, FIRSTREF>(pA0, pA1, mhat, negm, alA, mb0, hi);
  ROT();
  for (int j = 1; j + 1 < NT; j += 2) {
    LBAR();
    SBAR(); qkt<ND0>(pB0, pB1, K_lds + cur, qr, negm, r32, hi, kb0);
    SWRITE(nxt); if (j + 2 < NT) SLOAD((j + 2) * KVBLK); SBAR();
    finishSM(pA0, pA1, alA, l_reg, pa0, pa1, pa2, pa3); SBAR();
    pv_d0(o, vb0 + prv, pa0, pa1, pa2, pa3); partialSM<MASK, false>(pB0, pB1, mhat, negm, alB, mb0 + j * KVBLK, hi);
    RESC(alB); ROT();
    LBAR();
    SBAR(); qkt<ND0>(pA0, pA1, K_lds + cur, qr, negm, r32, hi, kb0);
    SWRITE(nxt); if (j + 3 < NT) SLOAD((j + 3) * KVBLK); SBAR();
    finishSM(pB0, pB1, alB, l_reg, pa0, pa1, pa2, pa3); SBAR();
    pv_d0(o, vb0 + prv, pa0, pa1, pa2, pa3); partialSM<MASK, false>(pA0, pA1, mhat, negm, alA, mb0 + (j + 1) * KVBLK, hi);
    RESC(alA); ROT();
  }
  LBAR();
  SBAR(); qkt<ND0>(pB0, pB1, K_lds + cur, qr, negm, r32, hi, kb0);
  finishSM(pA0, pA1, alA, l_reg, pa0, pa1, pa2, pa3); SBAR();
  pv_d0(o, vb0 + prv, pa0, pa1, pa2, pa3); partialSM<MASK, false>(pB0, pB1, mhat, negm, alB, mb0 + (NT - 1) * KVBLK, hi);
  RESC(alB);
  finishSM(pB0, pB1, alB, l_reg, pa0, pa1, pa2, pa3); SBAR();
  pv_d0(o, vb0 + cur, pa0, pa1, pa2, pa3);
  __syncthreads();
#undef SLOAD
#undef SWRITE
#undef RESC
#undef ROT
#undef LBAR
}
}
constexpr int DM = 2048, NTOK = 32768  , DEPTH = 4, AB_IN = 5120, C_INW = 3072, DFF = 8192;
constexpr float EPS = 1e-6f;
constexpr size_t MiB = 1u << 20;
constexpr size_t WS_CTL = 0, CTL_ZERO_BYTES = 1 * MiB;
constexpr size_t WS_TABB = 1 * MiB, WS_TABC = 2 * MiB, WS_MISC = 4 * MiB, WS_R2 = 5 * MiB;
constexpr size_t WS_WINAB = 8 * MiB, WS_WOUTAB = 48 * MiB, WS_WINC = 64 * MiB, WS_WOUTC = 88 * MiB, WS_WUP = 104 * MiB, WS_WDOWN = 232 * MiB;
constexpr size_t WS_H = 360 * MiB, WS_Z = 488 * MiB, WS_CAT = 808 * MiB, WS_HID = 488 * MiB, WS_OUT = 1000 * MiB, WS_END = 1128 * MiB;
static_assert(WS_WINAB + 2ull * AB_IN * DM * 2 <= WS_WOUTAB && WS_WOUTAB + 2ull * DM * DM * 2 <= WS_WINC && WS_WINC + 2ull * C_INW * DM * 2 <= WS_WOUTC && WS_WOUTC + 2ull * DM * DM * 2 <= WS_WUP &&
              WS_WUP + 4ull * DFF * DM * 2 <= WS_WDOWN && WS_WDOWN + 4ull * DFF * DM * 2 <= WS_H && WS_H + (size_t)NTOK * DM * 2 <= WS_Z && WS_Z + (size_t)NTOK * AB_IN * 2 <= WS_CAT &&
              WS_CAT + (size_t)NTOK * DM * 2 <= WS_OUT && WS_HID + (size_t)NTOK * DFF * 2 <= WS_OUT && WS_OUT + (size_t)NTOK * DM * 2 <= WS_END, "d_ws map");
constexpr int CW_BAR = 4096;
constexpr int NWAVES = 8;
constexpr int LDS_BYTES = 147456, RING_BYTES = 131072, MISC_OFF = RING_BYTES + 320;

#define GAS __attribute__((address_space(1)))
#define LAS __attribute__((address_space(3)))
typedef unsigned short bf16;
typedef unsigned v4u __attribute__((ext_vector_type(4)));
typedef unsigned v2u __attribute__((ext_vector_type(2)));
typedef float f32x4 __attribute__((ext_vector_type(4)));
typedef short bf16x8 __attribute__((ext_vector_type(8)));
typedef GAS unsigned gu32;
#define RLX_AGENT __ATOMIC_RELAXED, __HIP_MEMORY_SCOPE_AGENT
#define LDS_WAIT() asm volatile("s_waitcnt lgkmcnt(0)" ::: "memory")
__device__ __forceinline__ unsigned f2bf(float f) { unsigned u = __builtin_bit_cast(unsigned, f); return (u + 0x7fffu + ((u >> 16) & 1u)) >> 16; }
__device__ __forceinline__ unsigned pk2(float lo, float hi) { return f2bf(lo) | (f2bf(hi) << 16); }
__device__ __forceinline__ float bflo(unsigned w) { return __uint_as_float(w << 16); }
__device__ __forceinline__ float bfhi(unsigned w) { return __uint_as_float(w & 0xffff0000u); }

#define XB_TMO      128
#define XB_XCNT(j)  (256  + 64 * (j))
#define XB_XSUB(j)  (1280 + 64 * (j))
#define XB_XGEN(j)  (2304 + 64 * (j))
#define XB_TOP      3328
#define XB_TOPGEN   3392
#define XCD_BAR_WORDS 3456
#define XB_SPIN_CAP (1u << 18)

__device__ __forceinline__ unsigned xb_ld(unsigned* p)              { return __hip_atomic_load(p, __ATOMIC_RELAXED, __HIP_MEMORY_SCOPE_AGENT); }
__device__ __forceinline__ unsigned xb_add(unsigned* p, unsigned v) { return __hip_atomic_fetch_add(p, v, __ATOMIC_RELAXED, __HIP_MEMORY_SCOPE_AGENT); }
__device__ __forceinline__ unsigned xb_xcc_id() { return (unsigned)__builtin_amdgcn_s_getreg((3 << 11) | 20) & 0xFu; }
#define XB_SPIN(cond, bar) do { unsigned _sp = 0; while (cond) { __builtin_amdgcn_s_sleep(1); \
    if ((++_sp & 255u) == 0u) { if (xb_ld(&(bar)[XB_TMO])) break; if (_sp > XB_SPIN_CAP) { atomicAdd(&(bar)[XB_TMO], 1u); break; } } } } while (0)

struct XcdBarrier {
    unsigned* bar; unsigned x; unsigned wv;
    volatile LAS unsigned* st;
};

__device__ __forceinline__ XcdBarrier xcd_barrier_post(unsigned* bar, volatile LAS unsigned* st) {
    XcdBarrier b; b.bar = bar; b.x = xb_xcc_id(); b.st = st; b.wv = (unsigned)__builtin_amdgcn_readfirstlane(threadIdx.x >> 6);
    if (threadIdx.x == 0) (void)xb_add(&bar[XB_XCNT(b.x)], 1u);
    return b;
}
__device__ __forceinline__ void xcd_barrier_complete(unsigned* bar, unsigned x, unsigned& nloc, unsigned& nx) {
    const unsigned G = gridDim.x * gridDim.y * gridDim.z;
    unsigned sum, cnt, mine, sp = 0u;
    for (;;) {
        sum = 0u; cnt = 0u; mine = 0u;
#pragma unroll
        for (unsigned j = 0; j < 16; ++j) { const unsigned c = xb_ld(&bar[XB_XCNT(j)]); sum += c; cnt += (c > 0u) ? 1u : 0u; mine = (j == x) ? c : mine; }
        if (sum == G) break;
        __builtin_amdgcn_s_sleep(1);
        if ((++sp & 255u) == 0u) { if (xb_ld(&bar[XB_TMO])) break; if (sp > XB_SPIN_CAP) { atomicAdd(&bar[XB_TMO], 1u); break; } }
    }
    nloc = mine > 0u ? mine : 1u; nx = cnt > 0u ? cnt : 1u;
}

__device__ __forceinline__ void xcd_barrier(const XcdBarrier& b) {
    asm volatile("s_waitcnt vmcnt(0)" ::: "memory");
    __syncthreads();
    if (b.wv == 0u && lane_id_v() == 0) {
        unsigned* bar = b.bar; unsigned bx = b.x; asm volatile("" : "+s"(bx));
        __builtin_amdgcn_s_waitcnt(0);
        unsigned nloc = b.st[0], nx = b.st[1];
        if (nloc == 0u) { xcd_barrier_complete(bar, bx, nloc, nx); b.st[0] = nloc; b.st[1] = nx; }
        const unsigned old = xb_add(&bar[XB_XSUB(bx)], 1u);
        const unsigned gen = old / nloc;
        if (old + 1u == (gen + 1u) * nloc) {
            __builtin_amdgcn_fence(__ATOMIC_RELEASE, "agent");
            asm volatile("s_waitcnt vmcnt(0)" ::: "memory");
            const unsigned og = xb_add(&bar[XB_TOP], 1u);
            const unsigned tg = og / nx;
            if (og + 1u == (tg + 1u) * nx) xb_add(&bar[XB_TOPGEN], 1u);
            else XB_SPIN(xb_ld(&bar[XB_TOPGEN]) == tg, bar);
            __builtin_amdgcn_fence(__ATOMIC_ACQUIRE, "agent");
            xb_add(&bar[XB_XGEN(bx)], 1u);
            asm volatile("s_waitcnt vmcnt(0)" ::: "memory");
        } else {
            XB_SPIN(xb_ld(&bar[XB_XGEN(bx)]) == gen, bar);
            __builtin_amdgcn_fence(__ATOMIC_ACQUIRE, "agent");
            asm volatile("s_waitcnt vmcnt(0)" ::: "memory");
        }
    }
    __syncthreads();
}
__device__ const double ROPE_INV[16] = { 1.0, 0.44036660267178046, 0.19392274474868576, 0.08539710028576561, 0.03760603093086393, 0.016560440080994446, 0.007292664737217109,
    0.003211445994752591, 0.001414213562373095, 0.000622772421914596, 0.0002742481756762073, 0.00012076973741146504, 5.318295896944988e-05, 2.341999896140934e-05,
    1.031338537721246e-05, 4.5416704806078695e-06 };
__device__ __forceinline__ void sincos_d(double a, float& s, float& c) {
    const double k = rint(a * 0.63661977236758134308);
    double y = fma(-k, 1.57079632679489655800e+00, a); y = fma(-k, 6.12323399573676603587e-17, y);
    const double y2 = y * y;
    double sp = -7.647163731819816e-13; sp = fma(sp, y2, 1.6059043836821613e-10); sp = fma(sp, y2, -2.505210838544172e-08); sp = fma(sp, y2, 2.7557319223985893e-06);
    sp = fma(sp, y2, -1.984126984126984e-04); sp = fma(sp, y2, 8.333333333333333e-03); sp = fma(sp, y2, -1.6666666666666666e-01); sp = fma(sp * y2, y, y);
    double cp = 4.779477332387385e-14; cp = fma(cp, y2, -1.1470745597729725e-11); cp = fma(cp, y2, 2.08767569878681e-09); cp = fma(cp, y2, -2.755731922398589e-07);
    cp = fma(cp, y2, 2.48015873015873e-05); cp = fma(cp, y2, -1.388888888888889e-03); cp = fma(cp, y2, 4.1666666666666664e-02); cp = fma(cp, y2, -0.5); cp = fma(cp, y2, 1.0);
    const int q = ((int)((long long)k)) & 3;
    const double ss = (q & 1) ? cp : sp, cc = (q & 1) ? sp : cp;
    s = (float)((q & 2) ? -ss : ss); c = (float)(((q + 1) & 2) ? -cc : cc);
}
__device__ __forceinline__ float wave_sum(float v) {
    v = xor_add<1>(v); v = xor_add<2>(v); v = xor_add<4>(v); v = xor_add<8>(v); v = xor_add<16>(v); v = xor_add<32>(v);
    return v;
}
__device__ __forceinline__ void p0_transpose_item(const float* W, int K, int N, bf16* WT, LAS float* scr, int item, int lane, const float* gk) {
    const int nblk = N / 32, kb = item / nblk, nb = item % nblk, k0 = 64 * kb, n0 = 32 * nb;
#pragma unroll 8
    for (int i = 0; i < 32; ++i) { const int kk = 2 * i + (lane >> 5); scr[kk * 33 + (lane & 31)] = W[(size_t)(k0 + kk) * N + n0 + (lane & 31)] * (gk ? gk[k0 + kk] : 1.f); }
    LDS_WAIT(); asm volatile("" ::: "memory");
    const int c = lane & 7;
#pragma unroll
    for (int j = 0; j < 4; ++j) { const int n = (lane >> 3) + 8 * j; const LAS float* s = scr + (8 * c) * 33 + n;
        v4u o; o.x = pk2(s[0 * 33], s[1 * 33]); o.y = pk2(s[2 * 33], s[3 * 33]); o.z = pk2(s[4 * 33], s[5 * 33]); o.w = pk2(s[6 * 33], s[7 * 33]);
        *(GAS v4u*)(WT + (size_t)(n0 + n) * K + k0 + 8 * c) = o; }
    LDS_WAIT(); asm volatile("" ::: "memory");
}

struct Args { const float* in[18]; float* out; unsigned char* ws; int ph_lo, ph_hi; };

__device__ __forceinline__ void prologue(const Args& a, LAS unsigned char* lds, int gw, int NGW, int lane, int wave) {
    unsigned char* ws = a.ws;
    LAS float* scr = (LAS float*)(lds + wave * 16384);
    constexpr int I0 = 32 * 160, I1 = 32 * 64, I2 = 32 * 96, I3 = 32 * 64, I4 = 32 * 256, I5 = 128 * 64;
    constexpr int NITEMS = 2 * I0 + 2 * I1 + 2 * I2 + 2 * I3 + 4 * I4 + 4 * I5;
    for (int it = gw; it < NITEMS; it += NGW) {
        int r = it;
        if (r < 2 * I0) { const int j = r / I0; p0_transpose_item(a.in[6] + (size_t)j * DM * AB_IN, DM, AB_IN, (bf16*)(ws + WS_WINAB) + (size_t)j * AB_IN * DM, scr, r % I0, lane, a.in[2] + (2 * j) * DM); continue; } r -= 2 * I0;
        if (r < 2 * I1) { const int j = r / I1; p0_transpose_item(a.in[7] + (size_t)j * DM * DM, DM, DM, (bf16*)(ws + WS_WOUTAB) + (size_t)j * DM * DM, scr, r % I1, lane, nullptr); continue; } r -= 2 * I1;
        if (r < 2 * I2) { const int j = r / I2; p0_transpose_item(a.in[13] + (size_t)j * DM * C_INW, DM, C_INW, (bf16*)(ws + WS_WINC) + (size_t)j * C_INW * DM, scr, r % I2, lane, a.in[2] + (2 * j + 1) * DM); continue; } r -= 2 * I2;
        if (r < 2 * I3) { const int j = r / I3; p0_transpose_item(a.in[14] + (size_t)j * DM * DM, DM, DM, (bf16*)(ws + WS_WOUTC) + (size_t)j * DM * DM, scr, r % I3, lane, nullptr); continue; } r -= 2 * I3;
        if (r < 4 * I4) { const int j = r / I4; p0_transpose_item(a.in[16] + (size_t)j * DM * DFF, DM, DFF, (bf16*)(ws + WS_WUP) + (size_t)j * DFF * DM, scr, r % I4, lane, a.in[4] + j * DM); continue; } r -= 4 * I4;
        { const int j = r / I5; p0_transpose_item(a.in[17] + (size_t)j * DFF * DM, DFF, DM, (bf16*)(ws + WS_WDOWN) + (size_t)j * DM * DFF, scr, r % I5, lane, nullptr); }
    }
    float* tabB = (float*)(ws + WS_TABB); float* tabC = (float*)(ws + WS_TABC);
    for (int e = gw * 64 + lane; e < 16384 * 24; e += NGW * 64) {
        if (e < 16384 * 8) { const int pos = e >> 3, j = e & 7; float s, c; sincos_d((double)pos * ROPE_INV[2 * j], s, c); tabB[pos * 16 + j] = c; tabB[pos * 16 + 8 + j] = s; }
        else { const int e2 = e - 16384 * 8, pos = e2 >> 4, j = e2 & 15; float s, c; sincos_d((double)pos * ROPE_INV[j], s, c); tabC[pos * 32 + j] = c; tabC[pos * 32 + 16 + j] = s; }
    }
    if (gw == 0 && lane < 2) {
        const float* lv = a.in[11] + lane * 256; float d0 = 0.f, d1 = 0.f;
        for (int i = 0; i < 64; ++i) { d0 += lv[i] * lv[64 + i]; d1 += lv[128 + i] * lv[192 + i]; }
        const float li = lane == 0 ? 0.2f : 0.4707130183435842f;
        float* misc = (float*)(ws + WS_MISC);
        misc[lane] = __builtin_amdgcn_exp2f(d0 * 1.4426950408889634f) - __builtin_amdgcn_exp2f(d1 * 1.4426950408889634f) + li;
        misc[2 + lane] = 1.0f - li;
    }
}

template <int MODE, int RB>
__device__ __forceinline__ void rowpass(const float* xin, float* xout, bf16* XB, const bf16* OUT, const float* gpost, float* R2, int gw, int NGW, int lane) {
    f32x4 gp[4][2];
    if (MODE != 0) {
#pragma unroll
        for (int k = 0; k < 4; ++k) { gp[k][0] = *(const f32x4*)(gpost + 512 * k + 8 * lane); gp[k][1] = *(const f32x4*)(gpost + 512 * k + 8 * lane + 4); }
    }
    for (int row0 = gw * RB; row0 < NTOK; row0 += NGW * RB) {
        v4u xw[RB][4], ow[RB][4]; f32x4 xf[RB][4][2];
#pragma unroll
        for (int rb = 0; rb < RB; ++rb) {
            const int row = row0 + rb;
            if (MODE == 0) {
                const GAS f32x4* xr = (const GAS f32x4*)(xin + (size_t)row * DM) + 2 * lane;
#pragma unroll
                for (int k = 0; k < 4; ++k) { xf[rb][k][0] = xr[128 * k]; xf[rb][k][1] = xr[128 * k + 1]; }
            } else {
                const GAS v4u* xr = (const GAS v4u*)(XB + (size_t)row * DM) + lane;
                const GAS v4u* orow = (const GAS v4u*)(OUT + (size_t)row * DM) + lane;
#pragma unroll
                for (int k = 0; k < 4; ++k) { xw[rb][k] = __builtin_nontemporal_load(xr + 64 * k); ow[rb][k] = __builtin_nontemporal_load(orow + 64 * k); }
            }
        }
#pragma unroll
        for (int rb = 0; rb < RB; ++rb) {
            const int row = row0 + rb;
            f32x4 x[4][2];
            if (MODE == 0) {
#pragma unroll
                for (int k = 0; k < 4; ++k) { x[k][0] = xf[rb][k][0]; x[k][1] = xf[rb][k][1]; }
            } else {
                f32x4 o[4][2]; float ss = 0.f;
#pragma unroll
                for (int k = 0; k < 4; ++k) { const v4u w = ow[rb][k]; o[k][0] = (f32x4){bflo(w.x), bfhi(w.x), bflo(w.y), bfhi(w.y)}; o[k][1] = (f32x4){bflo(w.z), bfhi(w.z), bflo(w.w), bfhi(w.w)};
#pragma unroll
                    for (int h = 0; h < 2; ++h) ss += (o[k][h].x * o[k][h].x + o[k][h].y * o[k][h].y) + (o[k][h].z * o[k][h].z + o[k][h].w * o[k][h].w); }
                const float r1 = 1.0f / sqrtf(wave_sum(ss) * (1.0f / DM) + EPS);
#pragma unroll
                for (int k = 0; k < 4; ++k) { const v4u w = xw[rb][k];
                    x[k][0] = (f32x4){bflo(w.x), bfhi(w.x), bflo(w.y), bfhi(w.y)} + (o[k][0] * r1) * gp[k][0];
                    x[k][1] = (f32x4){bflo(w.z), bfhi(w.z), bflo(w.w), bfhi(w.w)} + (o[k][1] * r1) * gp[k][1]; }
            }
            if (MODE == 2) {
                GAS f32x4* xo = (GAS f32x4*)(xout + (size_t)row * DM) + 2 * lane;
#pragma unroll
                for (int k = 0; k < 4; ++k) { xo[128 * k] = x[k][0]; xo[128 * k + 1] = x[k][1]; }
            } else {
                float s2 = 0.f;
#pragma unroll
                for (int k = 0; k < 4; ++k)
#pragma unroll
                    for (int h = 0; h < 2; ++h) s2 += (x[k][h].x * x[k][h].x + x[k][h].y * x[k][h].y) + (x[k][h].z * x[k][h].z + x[k][h].w * x[k][h].w);
                const float r2 = 1.0f / sqrtf(wave_sum(s2) * (1.0f / DM) + EPS);
                if (lane == 0) R2[row] = r2;
                GAS v4u* xo = (GAS v4u*)(XB + (size_t)row * DM) + lane;
#pragma unroll
                for (int k = 0; k < 4; ++k) { v4u w; w.x = pk2(x[k][0].x, x[k][0].y); w.y = pk2(x[k][0].z, x[k][0].w); w.z = pk2(x[k][1].x, x[k][1].y); w.w = pk2(x[k][1].z, x[k][1].w); xo[64 * k] = w; }
            }
        }
    }
}

__device__ __forceinline__ void gmlp_unit(const bf16* Zc, bf16* CATc, int g, const float* wsg, const float* bsg, const float* vng, char* lds, const int wv) {
    using att::f32x16;
    const int tid = opaque_tid(wv), wid = tid >> 6, lane = tid & 63, r32 = lane & 31, hi = lane >> 5;
    bf16* vT = (bf16*)lds; float* mx = (float*)(lds + 36864);
    const int row = tid >> 2, cq = (tid & 3) * 8;
    {
        const bf16* vp = Zc + (size_t)row * AB_IN + 1024 + g * 128 + cq;
        float v[32]; float ss = 0.f;
#pragma unroll
        for (int i = 0; i < 4; ++i) { const v4u w = *(const v4u*)(vp + 32 * i);
            v[8 * i + 0] = bflo(w.x); v[8 * i + 1] = bfhi(w.x); v[8 * i + 2] = bflo(w.y); v[8 * i + 3] = bfhi(w.y); v[8 * i + 4] = bflo(w.z); v[8 * i + 5] = bfhi(w.z); v[8 * i + 6] = bflo(w.w); v[8 * i + 7] = bfhi(w.w); }
#pragma unroll
        for (int i = 0; i < 32; ++i) ss += v[i] * v[i];
        ss = xor_add<1>(ss); ss = xor_add<2>(ss);
        const float rn = 1.0f / sqrtf(ss * (1.0f / 128.0f) + EPS);
        const int qrot = (row + 16 * (tid & 3)) & 127;
#pragma unroll
        for (int i = 0; i < 4; ++i) { const f32x4 g0 = *(const f32x4*)(vng + 32 * i + cq), g1 = *(const f32x4*)(vng + 32 * i + cq + 4);
#pragma unroll
            for (int e2 = 0; e2 < 8; ++e2) vT[(32 * i + cq + e2) * 136 + qrot] = (bf16)f2bf(v[8 * i + e2] * rn * (e2 < 4 ? g0[e2 & 3] : g1[e2 & 3])); }
    }
    __syncthreads();
    const int pb = wid & 3, ch = wid >> 2;
    f32x16 acc[2] = {};
    const float* wrow = wsg + (32 * pb + r32) * 128 + 8 * hi;
    const int frot = 16 * ((r32 >> 3) & 3);
#pragma unroll
    for (int ks = 0; ks < 8; ++ks) {
        const f32x4 a0 = *(const f32x4*)(wrow + 16 * ks), a1 = *(const f32x4*)(wrow + 16 * ks + 4);
        v4u aw = {att::cvtpk(a0.x, a0.y), att::cvtpk(a0.z, a0.w), att::cvtpk(a1.x, a1.y), att::cvtpk(a1.z, a1.w)};
        const bf16x8 A = *reinterpret_cast<bf16x8*>(&aw);
#pragma unroll
        for (int cb = 0; cb < 2; ++cb) { const bf16x8 B = *(const bf16x8*)((const char*)vT + ((64 * ch + 32 * cb + r32) * 136 + ((16 * ks + 8 * hi + frot) & 127)) * 2);
            acc[cb] = __builtin_amdgcn_mfma_f32_32x32x16_bf16(A, B, acc[cb], 0, 0, 0); }
    }
#pragma unroll
    for (int r = 0; r < 16; ++r) { const int p = 32 * pb + att::crow(r, hi); const float bias = bsg[p];
#pragma unroll
        for (int cb = 0; cb < 2; ++cb) mx[p * 132 + 64 * ch + 32 * cb + r32] = acc[cb][r] + bias; }
    __syncthreads();
    {
        const bf16* up = Zc + (size_t)row * AB_IN + g * 128 + cq; bf16* op = CATc + (size_t)row * DM + g * 128 + cq;
#pragma unroll
        for (int i = 0; i < 4; ++i) { const v4u w = *(const v4u*)(up + 32 * i);
            const f32x4 m0 = *(const f32x4*)(mx + row * 132 + 32 * i + cq), m1 = *(const f32x4*)(mx + row * 132 + 32 * i + cq + 4);
            v4u o; o.x = pk2(bflo(w.x) * m0.x, bfhi(w.x) * m0.y); o.y = pk2(bflo(w.y) * m0.z, bfhi(w.y) * m0.w); o.z = pk2(bflo(w.z) * m1.x, bfhi(w.z) * m1.y); o.w = pk2(bflo(w.w) * m1.z, bfhi(w.w) * m1.w);
            *(v4u*)(op + 32 * i) = o; }
    }
    __syncthreads();
}

#define O_STAGE_STORE(VAL, stg, dst, ldd) do { \
    _Pragma("unroll") for (int r = 0; r < 16; ++r) { const int orow_ = att::crow(r, hi); \
        _Pragma("unroll") for (int d0 = 0; d0 < 4; ++d0) (stg)[orow_ * 136 + d0 * 32 + r32] = (bf16)f2bf(VAL(d0, r)); } \
    asm volatile("s_waitcnt lgkmcnt(0)" ::: "memory"); \
    _Pragma("unroll") for (int i_ = 0; i_ < 8; ++i_) { const int pi_ = i_ * 64 + lane, prow_ = pi_ >> 4, pch_ = pi_ & 15; \
        const v4u w_ = *(const v4u*)((stg) + prow_ * 136 + pch_ * 8); *(v4u*)((dst) + (long)prow_ * (ldd) + pch_ * 8) = w_; } \
    asm volatile("s_waitcnt lgkmcnt(0)" ::: "memory"); } while (0)

__device__ __forceinline__ void diff_attn_unit(const bf16* Zs, bf16* CATs, int S, int h, int qb, float lam, float oscale, const float* subg, char* lds, const int wv) {
    using namespace att;
    const int tid = opaque_tid(wv), wid = tid >> 6, lane = tid & 63, r32 = lane & 31, hi = lane >> 5, br = wid >> 2, wq = wid & 3;
    const long ld = AB_IN;
    const bf16* Qw = Zs + (long)(qb * 128 + wq * 32 + r32) * ld + 2048 + (br * 8 + h) * 64 + hi * 8;
    bf16x8 qr[4];
#pragma unroll
    for (int d0 = 0; d0 < 4; ++d0) qr[d0] = *(const bf16x8*)(Qw + d0 * 16);
    const int sr = tid >> 4, sc = (tid & 15) * 8;
    const bf16* Kt = Zs + (long)sr * ld + 3072 + h * 64 + (sc < 64 ? sc : 448 + sc);
    const bf16* Vt = Zs + (long)sr * ld + 4096 + h * 128 + sc;
    f32x16 o[4] = {}; float l = 0.f;
    attn_core_ring<4, false, true>(qr, Kt, Vt, ld, S / 64, 0, br * 4, 0.f, l, o, lds, wv);
    float* li_l = (float*)(lds + RING_SCR) + wid * 64;
    if (hi == 0) li_l[r32] = l;
    asm volatile("s_waitcnt lgkmcnt(0)" ::: "memory");
    float rli[16];
#pragma unroll
    for (int r = 0; r < 16; ++r) rli[r] = __builtin_amdgcn_rcpf(li_l[crow(r, hi)]);
    __syncthreads();
    float* cbuf = (float*)lds + wq * 4096;
    if (br == 1) {
#pragma unroll
        for (int d0 = 0; d0 < 4; ++d0)
#pragma unroll
            for (int r = 0; r < 16; ++r) cbuf[(d0 * 16 + r) * 64 + lane] = o[d0][r] * rli[r];
    }
    __syncthreads();
    if (br == 0) {
        float g4[4];
#pragma unroll
        for (int d0 = 0; d0 < 4; ++d0) g4[d0] = subg[d0 * 32 + r32] * oscale;
        float rn[16];
#pragma unroll
        for (int r = 0; r < 16; ++r) {
            float ss = 0.f;
#pragma unroll
            for (int d0 = 0; d0 < 4; ++d0) { const float v = o[d0][r] * rli[r] - lam * cbuf[(d0 * 16 + r) * 64 + lane]; o[d0][r] = v; ss += v * v; }
            ss = xor_add<1>(ss); ss = xor_add<2>(ss); ss = xor_add<4>(ss); ss = xor_add<8>(ss); ss = xor_add<16>(ss);
            rn[r] = 1.0f / sqrtf(ss * (1.0f / 128.0f) + EPS);
        }
        asm volatile("s_waitcnt lgkmcnt(0)" ::: "memory");
        bf16* stg = (bf16*)cbuf; bf16* dst = CATs + (long)(qb * 128 + wq * 32) * DM + 1024 + h * 128;
#define DVAL(d0, r) (o[d0][r] * rn[r] * g4[d0])
        O_STAGE_STORE(DVAL, stg, dst, DM);
#undef DVAL
    }
    __syncthreads();
}

#ifndef WIN_SKIP
#define WIN_SKIP false
#endif
__device__ __forceinline__ void win_attn_unit(const bf16* Zs, bf16* CATs, int S, int hp, int qb, const float* sinks, char* lds, const int wv) {
    using namespace att;
    const int tid = opaque_tid(wv), wid = tid >> 6, lane = tid & 63, r32 = lane & 31, hi = lane >> 5;
    const long ld = C_INW; const int hq = 2 * hp + (wid >> 2), kvh = hp >> 1, q0 = qb * 128, qw = q0 + (wid & 3) * 32;
    const int klo = q0 - 128 < 0 ? 0 : q0 - 128, khi = q0 + 256 > S ? S : q0 + 256, NT = (khi - klo) / 64;
    const bf16* Qw = Zs + (long)(qw + r32) * ld + hq * 128 + hi * 8;
    bf16x8 qr[8];
#pragma unroll
    for (int d0 = 0; d0 < 8; ++d0) qr[d0] = *(const bf16x8*)(Qw + d0 * 16);
    const int sr = tid >> 4, sc = (tid & 15) * 8;
    const bf16* Kt = Zs + (long)(klo + sr) * ld + 2048 + kvh * 128 + sc;
    const bf16* Vt = Zs + (long)(klo + sr) * ld + 2560 + kvh * 128 + sc;
    f32x16 o[4] = {}; float l = 1.f;
    attn_core<8, true, 1, false, WIN_SKIP>(qr, Kt, Vt, ld, NT, klo - (qw + r32), 0, sinks[hq] * 1.4426950408889634f, l, o, lds, wv);
    float* li_l = (float*)(lds + SHM_SCR) + wid * 64;
    if (hi == 0) li_l[r32] = l;
    asm volatile("s_waitcnt lgkmcnt(0)" ::: "memory");
    float rl[16];
#pragma unroll
    for (int r = 0; r < 16; ++r) rl[r] = __builtin_amdgcn_rcpf(li_l[crow(r, hi)]);
    __syncthreads();
    { bf16* stg = (bf16*)(lds + wid * 8704); bf16* dst = CATs + (long)qw * DM + hq * 128;
#define WVAL(d0, r) (o[d0][r] * rl[r])
      O_STAGE_STORE(WVAL, stg, dst, DM);
#undef WVAL
    }
    __syncthreads();
}
#ifndef REP0
#define REP0 1
#endif
#ifndef REP1
#define REP1 1
#endif
#ifndef REP2
#define REP2 1
#endif
#ifndef REP3
#define REP3 1
#endif
#ifndef REP4
#define REP4 1
#endif
#ifndef REP5
#define REP5 1
#endif
#ifndef REP6
#define REP6 1
#endif
#ifndef REP7
#define REP7 1
#endif
#ifndef REP8
#define REP8 1
#endif
#ifndef REP9
#define REP9 1
#endif
#ifndef REP10
#define REP10 1
#endif
#ifndef PHASE_MASK
#define PHASE_MASK 0xFFFF
#endif
#ifndef MK_SPLIT
#define MK_SPLIT 0
#endif
constexpr int N_PHASES = 1 + 2 * (1 + 4 * 7);
__global__ void __launch_bounds__(NWAVES * 64, 2) fwd_kernel(Args a) {
    extern __shared__ __attribute__((aligned(16))) unsigned char lds[];
    LAS unsigned char* L = (LAS unsigned char*)lds;
    const int tid = threadIdx.x, wave = __builtin_amdgcn_readfirstlane(tid >> 6);
    const int G = gridDim.x, c = blockIdx.x;
    volatile LAS unsigned* MISC = (volatile LAS unsigned*)(L + MISC_OFF);
    for (int u = tid; u < (LDS_BYTES - RING_BYTES) / 4; u += NWAVES * 64) ((LAS unsigned*)(L + RING_BYTES))[u] = 0u;
    __syncthreads();
    unsigned char* ws0 = a.ws;
#define KARG ({ const __attribute__((address_space(4))) Args* p_ = (const __attribute__((address_space(4))) Args*)__builtin_amdgcn_kernarg_segment_ptr(); asm volatile("" : "+s"(p_)); p_; })
#define ws ({ GAS unsigned char* w_ = (GAS unsigned char*)ws0; asm volatile("" : "+s"(w_)); (unsigned char*)w_; })
#define AIN(k) ((const float*)(const GAS float*)KARG->in[k])
    unsigned* ctl = (unsigned*)(ws0 + WS_CTL);
    XcdBarrier bar = xcd_barrier_post(ctl + CW_BAR, MISC + 8);
#define IN() true
#define SEAM() xcd_barrier(bar)
    const int gw = c * NWAVES + wave, NGW = G * NWAVES;
    const bool x8 = (G & 7) == 0; const int xcd = c & 7, xr = c >> 3, xper = G >> 3;
#define H ((bf16*)(ws + WS_H))
#define R2 ((float*)(ws + WS_R2))
#define Z ((bf16*)(ws + WS_Z))
#define CAT ((bf16*)(ws + WS_CAT))
#define HID ((bf16*)(ws + WS_HID))
#define OUT ((bf16*)(ws + WS_OUT))
#define tabB ((const float*)(ws + WS_TABB))
#define tabC ((const float*)(ws + WS_TABC))
#define misc ((const float*)(ws + WS_MISC))

    if (IN() && ((PHASE_MASK >> 0) & 1)) { for (int rep_ = 0; rep_ < REP0; ++rep_) { prologue(a, L, gw, NGW, (opaque_tid(wave) & 63), wave); } SEAM(); }

    for (int grp = 0; grp < 2; ++grp) {
        const int S = grp ? 16384 : 2048, smask = S - 1;
        if (IN() && ((PHASE_MASK >> 1) & 1)) { for (int rep_ = 0; rep_ < REP1; ++rep_) { rowpass<0, 2>(AIN(grp), nullptr, H, nullptr, nullptr, R2, gw, NGW, (opaque_tid(wave) & 63)); } SEAM(); }
        for (int l = 0; l < DEPTH; ++l) {
            const int j = l >> 1;
            if ((l & 1) == 0) {
                if (IN() && ((PHASE_MASK >> 2) & 1)) { for (int rep_ = 0; rep_ < REP2; ++rep_) {
                    pg8::Gemm g{H, (const bf16*)(ws + WS_WINAB) + (size_t)j * AB_IN * DM, NTOK, AB_IN, DM}; pg8::StaticOrder So; So.init(NTOK, AB_IN, G, c, 8);
                    pg8::EpiAct<2> E{Z, AB_IN, tabB, smask, R2};
                    pg8::gemm_phase<pg8::EpiAct<2>, pg8::StaticOrder, true, true>(L, g, So, E, wave);
                    } SEAM(); }
                if (IN() && ((PHASE_MASK >> 3) & 1)) { for (int rep_ = 0; rep_ < REP3; ++rep_) {
                    if ((PHASE_MASK >> 11) & 1) { const int U = (NTOK / 128) * 8; const int u0 = x8 ? xcd * (U / 8) + xr : c, u1 = x8 ? (xcd + 1) * (U / 8) : U, us = x8 ? xper : G;
                      for (int u = u0; u < u1; u += us) { const int chunk = u >> 3, g = u & 7;
                          gmlp_unit(Z + (size_t)chunk * 128 * AB_IN, CAT + (size_t)chunk * 128 * DM, g, AIN(9) + (size_t)(j * 8 + g) * 16384, AIN(10) + (j * 8 + g) * 128, AIN(8) + (j * 8 + g) * 128, (char*)lds, wave); } }
                    if ((PHASE_MASK >> 12) & 1) { const float lam = misc[j], osc = misc[2 + j]; const float* subg = AIN(12) + j * 128;
                      const int nqb = S / 128, U = (NTOK / 128) * 8; const int u0 = x8 ? xcd * (U / 8) + xr : c, u1 = x8 ? (xcd + 1) * (U / 8) : U, us = x8 ? xper : G;
                      for (int u = u0; u < u1; u += us) { const int pair = u / nqb, qb = u % nqb, b = pair >> 3, h = pair & 7;
                          diff_attn_unit(Z + (size_t)b * S * AB_IN, CAT + (size_t)b * S * DM, S, h, qb, lam, osc, subg, (char*)lds, wave); } }
                    } SEAM(); }
            } else {
                if (IN() && ((PHASE_MASK >> 4) & 1)) { for (int rep_ = 0; rep_ < REP4; ++rep_) {
                    pg8::Gemm g{H, (const bf16*)(ws + WS_WINC) + (size_t)j * C_INW * DM, NTOK, C_INW, DM}; pg8::StaticOrder So; So.init(NTOK, C_INW, G, c, 8);
                    pg8::EpiAct<3> E{Z, C_INW, tabC, smask, R2};
                    pg8::gemm_phase<pg8::EpiAct<3>, pg8::StaticOrder, true, true>(L, g, So, E, wave);
                    } SEAM(); }
                if (IN() && ((PHASE_MASK >> 5) & 1)) { for (int rep_ = 0; rep_ < REP5; ++rep_) {
                    const int nqb = S / 128, U = (NTOK / 128) * 8; const int u0 = x8 ? xcd * (U / 8) + xr : c, u1 = x8 ? (xcd + 1) * (U / 8) : U, us = x8 ? xper : G;
                    for (int u = u0; u < u1; u += us) { const int blk = u >> 3, hp = u & 7, b = blk / nqb, qb = blk % nqb;
                        win_attn_unit(Z + (size_t)b * S * C_INW, CAT + (size_t)b * S * DM, S, hp, qb, AIN(15) + j * 16, (char*)lds, wave); }
                    } SEAM(); }
            }
            if (IN() && ((PHASE_MASK >> 6) & 1)) { for (int rep_ = 0; rep_ < REP6; ++rep_) {
                const bf16* Wt = (l & 1) ? (const bf16*)(ws + WS_WOUTC) + (size_t)j * DM * DM : (const bf16*)(ws + WS_WOUTAB) + (size_t)j * DM * DM;
                pg8::Gemm g{CAT, Wt, NTOK, DM, DM}; pg8::StaticOrder So; So.init(NTOK, DM, G, c, 8);
                pg8::EpiAct<0> E{OUT, DM, nullptr, 0, nullptr};
                pg8::gemm_phase<pg8::EpiAct<0>, pg8::StaticOrder, true, true>(L, g, So, E, wave);
                } SEAM(); }
            if (IN() && ((PHASE_MASK >> 7) & 1)) { for (int rep_ = 0; rep_ < REP7; ++rep_) { rowpass<1, 4>(nullptr, nullptr, H, OUT, AIN(3) + l * DM, R2, gw, NGW, (opaque_tid(wave) & 63)); } SEAM(); }
            if (IN() && ((PHASE_MASK >> 8) & 1)) { for (int rep_ = 0; rep_ < REP8; ++rep_) {
                pg8::Gemm g{H, (const bf16*)(ws + WS_WUP) + (size_t)l * DFF * DM, NTOK, DFF, DM}; pg8::StaticOrder So; So.init(NTOK, DFF, G, c);
                pg8::EpiAct<1> E{HID, DFF, nullptr, 0, R2};
                pg8::gemm_phase<pg8::EpiAct<1>, pg8::StaticOrder, true, true>(L, g, So, E, wave);
                } SEAM(); }
            if (IN() && ((PHASE_MASK >> 9) & 1)) { for (int rep_ = 0; rep_ < REP9; ++rep_) {
                pg8::Gemm g{HID, (const bf16*)(ws + WS_WDOWN) + (size_t)l * DM * DFF, NTOK, DM, DFF}; pg8::StaticOrder So; So.init(NTOK, DM, G, c);
                pg8::EpiAct<0> E{OUT, DM, nullptr, 0, nullptr};
                pg8::gemm_phase<pg8::EpiAct<0>, pg8::StaticOrder, true, true>(L, g, So, E, wave);
                } SEAM(); }
            if (IN() && ((PHASE_MASK >> 10) & 1)) { for (int rep_ = 0; rep_ < REP10; ++rep_) { if (l + 1 < DEPTH) rowpass<1, 4>(nullptr, nullptr, H, OUT, AIN(5) + l * DM, R2, gw, NGW, (opaque_tid(wave) & 63)); else rowpass<2, 4>(nullptr, ((float*)(GAS float*)KARG->out) + (size_t)grp * NTOK * DM, H, OUT, AIN(5) + l * DM, nullptr, gw, NGW, (opaque_tid(wave) & 63)); } if (!(grp == 1 && l + 1 == DEPTH)) SEAM(); }
        }
    }
#undef IN
#undef SEAM
#undef ws
#undef KARG
#undef AIN
#undef H
#undef R2
#undef Z
#undef CAT
#undef HID
#undef OUT
#undef tabB
#undef tabC
#undef misc
}

extern "C" void kernel_launch(void* const* d_in, const int* in_sizes, int n_in, void* d_out, int out_size, void* d_ws, size_t ws_size, hipStream_t stream) {
    static int grid = 0;
    if (grid == 0) {
        if (n_in != 18 || in_sizes[0] != NTOK * DM || in_sizes[1] != NTOK * DM || out_size != 2 * NTOK * DM || ws_size < WS_END) {
            fprintf(stderr, "kernel_launch: unexpected shapes (n_in %d, in0 %d, out %d, ws %zu, need ws >= %zu); nothing launched\n", n_in, n_in > 0 ? in_sizes[0] : -1, out_size, ws_size, (size_t)WS_END); grid = -1; return; }
        int dev = 0, cus = 0;
        if (hipGetDevice(&dev) != hipSuccess || hipDeviceGetAttribute(&cus, hipDeviceAttributeMultiprocessorCount, dev) != hipSuccess) { grid = -1; return; }
        if (hipFuncSetAttribute((const void*)fwd_kernel, hipFuncAttributeMaxDynamicSharedMemorySize, LDS_BYTES) != hipSuccess) { fprintf(stderr, "kernel_launch: hipFuncSetAttribute failed\n"); grid = -1; return; }
        int per_cu = 0;
        if (hipOccupancyMaxActiveBlocksPerMultiprocessor(&per_cu, (const void*)fwd_kernel, NWAVES * 64, LDS_BYTES) != hipSuccess || per_cu < 1) { fprintf(stderr, "kernel_launch: occupancy query says %d blocks per CU\n", per_cu); }
        (void)hipGetLastError();
        grid = cus;
    }
    if (grid < 0) return;
    if (hipMemsetAsync((char*)d_ws + WS_CTL, 0, CTL_ZERO_BYTES, stream) != hipSuccess) return;
    Args a{};
    for (int i = 0; i < 18; ++i) a.in[i] = (const float*)d_in[i];
    a.out = (float*)d_out; a.ws = (unsigned char*)d_ws;
    a.ph_lo = 0; a.ph_hi = N_PHASES;
    hipLaunchKernelGGL(fwd_kernel, dim3(grid), dim3(NWAVES * 64), LDS_BYTES, stream, a);
    const hipError_t le = hipPeekAtLastError();
    if (le != hipSuccess) fprintf(stderr, "kernel_launch: launch failed: %s\n", hipGetErrorName(le));
}
```

```cpp
#include <hip/hip_runtime.h>
#include <hip/hip_bf16.h>
#include <cstdio>
#include <cstdint>
#include <cmath>
__device__ __forceinline__ int opaque_tid(int wv) { int t = (wv << 6) | (int)__builtin_amdgcn_mbcnt_hi(~0u, __builtin_amdgcn_mbcnt_lo(~0u, 0u)); asm volatile("" : "+v"(t)); return t; }
__device__ __forceinline__ int xor32_addr() { int a = (int)((__builtin_amdgcn_mbcnt_hi(~0u, __builtin_amdgcn_mbcnt_lo(~0u, 0u)) ^ 32u) << 2); asm volatile("" : "+v"(a)); return a; }
template <int K> __device__ __forceinline__ float xor_get(float v) {
    if constexpr (K < 32) return __builtin_bit_cast(float, __builtin_amdgcn_ds_swizzle(__builtin_bit_cast(int, v), (K << 10) | 0x1f));
    else return __builtin_bit_cast(float, __builtin_amdgcn_ds_bpermute(xor32_addr(), __builtin_bit_cast(int, v)));
}
template <int K> __device__ __forceinline__ float xor_add(float v) { return v + xor_get<K>(v); }
namespace pg8 {
#define PG8_LAS __attribute__((address_space(3)))
typedef unsigned short bf16_t;
typedef short bf16x8 __attribute__((ext_vector_type(8)));
typedef float f32x4 __attribute__((ext_vector_type(4)));
typedef unsigned u32x4 __attribute__((ext_vector_type(4)));
constexpr int BM = 256, BK = 64, HALF = 128, HTB = HALF * BK * 2  , STAGE_BYTES = 8 * HTB, NXCD = 8, WGM = 4;

__host__ __device__ __forceinline__ int lds_byte(int r, int c) { const int st = (r >> 4) * 2 + (c >> 5), rr = r & 15, cc = c & 31, ob = rr * 64 + cc * 2; return st * 1024 + (ob ^ (((ob >> 9) & 1) << 5)); }
__host__ __device__ __forceinline__ void stage_rc(int b, int& R, int& C) { const int st = b / 1024, sb = b % 1024, swz = sb ^ (((sb >> 9) & 1) << 5); R = (st >> 1) * 16 + swz / 64; C = (st & 1) * 32 + (swz % 64) / 2; }
__host__ __device__ __forceinline__ int perm32(int rho) { const int n = rho >> 4, i = rho & 15; return 8 * (i >> 2) + 4 * n + (i & 3); }

struct Unit { int pm, pn; };
struct Gemm { const bf16_t* A; const bf16_t* Bt; int M, N, K; };

struct StaticOrder {
    int nM, nN, nwg, G, c, wgm;
    __host__ __device__ void init(int M, int N, int G_, int c_, int wgm_ = WGM) { nM = M / BM; nN = N / BM; nwg = nM * nN; G = G_; c = c_; wgm = wgm_; }
    __host__ __device__ bool next(int i, Unit& u) const {
        const long L = (long)i * G + c; if (L >= nwg) return false;
        int wgid = (int)L; { const int q = nwg / NXCD, r = nwg % NXCD, xcd = wgid % NXCD, off = wgid / NXCD; wgid = (xcd < r ? xcd * (q + 1) : r * (q + 1) + (xcd - r) * q) + off; }
        const int nig = wgm * nN, gid = wgid / nig, fm = gid * wgm, gsz = (nM - fm) < wgm ? (nM - fm) : wgm;
        u.pm = fm + ((wgid % nig) % gsz); u.pn = (wgid % nig) / gsz; return true;
    }
    __device__ __forceinline__ void a_ready(const Unit&) const {}
    __device__ __forceinline__ void done(const Unit&) const {}
};

__device__ __forceinline__ unsigned cvt_pk_bf16(float lo, float hi) { unsigned r; asm volatile("v_cvt_pk_bf16_f32 %0, %1, %2" : "=v"(r) : "v"(lo), "v"(hi)); return r; }
typedef float f32x2 __attribute__((ext_vector_type(2)));
__device__ __forceinline__ float gelu_tanh(float x) {
    const float t = x * (2.3022082f + 0.10294324f * x * x);
    return x * __builtin_amdgcn_rcpf(1.0f + __builtin_amdgcn_exp2f(-t));
}
template <int MODE> struct EpiAct {
    static constexpr bool PERM = true, AFTER_DRAIN = false;
    bf16_t* O; int ldc; const float* tab; int smask; const float* rs;
    __device__ __forceinline__ void operator()(const f32x4 (&acc)[2][2][4][2], const Unit& u, int wr, int wc, int fr, int fq) const {
        const int row0 = u.pm * BM + wr * 64 + fr; const int colt = u.pn * BM;
        const int col0 = colt + wc * 32 + 8 * fq;
        int mode = 0;
        if (MODE == 1) mode = 1;
        if (MODE == 2) mode = colt < 2048 ? 2 : (colt < 4096 ? 3 : 0);
        if (MODE == 3) mode = colt < 2560 ? 4 : 0;
        const bool ropeB = (mode == 3) && ((wc & 1) == 0), ropeC = (mode == 4) && (wc == 0);
#pragma unroll
        for (int ai = 0; ai < 2; ++ai)
#pragma unroll
            for (int m = 0; m < 4; ++m) {
                const int row = row0 + ai * HALF + m * 16;
                bf16_t* rowp = O + (size_t)row * ldc + col0;
                const float rsc = (MODE != 0) ? rs[row] : 1.f;
                f32x4 c0 = {1.f, 1.f, 1.f, 1.f}, c1 = c0, s0 = {0.f, 0.f, 0.f, 0.f}, s1 = s0;
                if (MODE == 2) { if (ropeB) { const float* t = tab + (size_t)(row & smask) * 16; c0 = *(const f32x4*)t; c1 = *(const f32x4*)(t + 4); s0 = *(const f32x4*)(t + 8); s1 = *(const f32x4*)(t + 12); } }
                if (MODE == 3) { if (ropeC) { const float* t = tab + (size_t)(row & smask) * 32 + (fq & 1) * 8; c0 = *(const f32x4*)t; c1 = *(const f32x4*)(t + 4); s0 = *(const f32x4*)(t + 16); s1 = *(const f32x4*)(t + 20); } }
#pragma unroll
                for (int bj = 0; bj < 2; ++bj) {
                    f32x4 v0 = acc[ai][bj][m][0], v1 = acc[ai][bj][m][1];
                    if (MODE != 0) { v0 = v0 * rsc; v1 = v1 * rsc; }
                    if (MODE == 1) {
#pragma unroll
                        for (int j = 0; j < 4; ++j) { const float a = fmaxf(v0[j], 0.f), b = fmaxf(v1[j], 0.f); v0[j] = a * a; v1[j] = b * b; }
                    }
                    if (MODE == 2) {
                        if (mode == 2) {
#pragma unroll
                            for (int j = 0; j < 4; ++j) { v0[j] = gelu_tanh(v0[j]); v1[j] = gelu_tanh(v1[j]); }
                        }
                        if (ropeB) {
                            f32x4 o0, o1;
#pragma unroll
                            for (int j = 0; j < 4; ++j) { o0[j] = xor_get<16>(v0[j]); o1[j] = xor_get<16>(v1[j]); }
                            if (fq < 2) { const float sg = fq ? 1.f : -1.f; v0 = v0 * c0 + (o0 * s0) * sg; v1 = v1 * c1 + (o1 * s1) * sg; }
                        }
                    }
                    if (MODE == 3) {
                        if (ropeC) {
                            f32x4 o0, o1;
#pragma unroll
                            for (int j = 0; j < 4; ++j) { o0[j] = xor_get<32>(v0[j]); o1[j] = xor_get<32>(v1[j]); }
                            const float sg = (fq >= 2) ? 1.f : -1.f; v0 = v0 * c0 + (o0 * s0) * sg; v1 = v1 * c1 + (o1 * s1) * sg;
                        }
                    }
                    if (MODE == 2) { if (colt >= 2048 && colt < 3072) { v0 = v0 * 0.18033688011112042f; v1 = v1 * 0.18033688011112042f; } }
                    if (MODE == 3) { if (colt < 2048) { v0 = v0 * 0.12751743082459868f; v1 = v1 * 0.12751743082459868f; } }
                    u32x4 w; w.x = cvt_pk_bf16(v0[0], v0[1]); w.y = cvt_pk_bf16(v0[2], v0[3]); w.z = cvt_pk_bf16(v1[0], v1[1]); w.w = cvt_pk_bf16(v1[2], v1[3]);
                    if (MODE == 1) __builtin_nontemporal_store(w, (u32x4*)(rowp + bj * HALF));
                    else *(u32x4*)(rowp + bj * HALF) = w;
                }

            }
    }
};

template <class Epi, class Sched, bool ALIGN_EPI = false, bool SP2 = false, int AUXA = 0>
__device__ __forceinline__ void gemm_phase(PG8_LAS unsigned char* lds, const Gemm g, const Sched& S, const Epi& E, const int wv) {
    const int tid = opaque_tid(wv), wid = wv, lane = tid & 63, wr = wid >> 2, wc = wid & 3, fr = lane & 15, fq = lane >> 4;
    const int K = g.K, nt = K / BK;
    unsigned voffA[2], voffB[2];
#pragma unroll
    for (int i = 0; i < 2; ++i) { int R, C; stage_rc(tid * 16 + i * 8192, R, C); const int Rb = Epi::PERM ? ((R & ~31) + perm32(R & 31)) : R;
        voffA[i] = (unsigned)(R * K + C) * 2u; voffB[i] = (unsigned)(Rb * K + C) * 2u; }
    const size_t kstep = (size_t)(BK * 2);
    const size_t hstep = (size_t)HALF * K * 2;
    const size_t tstep = 2 * hstep;
    const unsigned ldsw = (unsigned)wid * 1024u;
    const int aoff = lds_byte(wr * 64 + fr, fq * 8), boff = lds_byte(wc * 32 + fr, fq * 8);
#define PG8_SA(b, h) (((b) * 2 + (h)) * HTB)
#define PG8_SB(b, h) ((4 + (b) * 2 + (h)) * HTB)
#define PG8_STAGE(bufoff, gbase, voff) do { _Pragma("unroll") for (int _i = 0; _i < 2; ++_i) \
        __builtin_amdgcn_global_load_lds((const unsigned*)((const char*)(gbase) + (voff)[_i]), (PG8_LAS unsigned*)(lds + (bufoff) + ldsw + _i * 8192), 16, 0, 0); } while (0)
#define PG8_STAGEA(bufoff, gbase, voff) do { _Pragma("unroll") for (int _i = 0; _i < 2; ++_i) \
        __builtin_amdgcn_global_load_lds((const unsigned*)((const char*)(gbase) + (voff)[_i]), (PG8_LAS unsigned*)(lds + (bufoff) + ldsw + _i * 8192), 16, 0, AUXA); } while (0)
#define PG8_LDA(dst, b, h) do { _Pragma("unroll") for (int m = 0; m < 4; ++m) _Pragma("unroll") for (int k = 0; k < 2; ++k) dst[m][k] = *(const PG8_LAS bf16x8*)(lds + PG8_SA(b, h) + aoff + m * 2048 + k * 1024); } while (0)
#define PG8_LDB(dst, b, h) do { _Pragma("unroll") for (int n = 0; n < 2; ++n) _Pragma("unroll") for (int k = 0; k < 2; ++k) dst[n][k] = *(const PG8_LAS bf16x8*)(lds + PG8_SB(b, h) + boff + n * 2048 + k * 1024); } while (0)
#define PG8_MMA(ai, bj, At, Bt) do { __builtin_amdgcn_s_setprio(1); _Pragma("unroll") for (int m = 0; m < 4; ++m) _Pragma("unroll") for (int n = 0; n < 2; ++n) _Pragma("unroll") for (int k = 0; k < 2; ++k) \
        acc[ai][bj][m][n] = __builtin_amdgcn_mfma_f32_16x16x32_bf16(Bt[n][k], At[m][k], acc[ai][bj][m][n], 0, 0, 0); __builtin_amdgcn_s_setprio(0); } while (0)
#define PG8_WAIT_V(n) asm volatile("s_waitcnt vmcnt(" #n ")" ::: "memory")
#define PG8_WAIT_L(n) asm volatile("s_waitcnt lgkmcnt(" #n ")" ::: "memory")
#define PG8_BAR __builtin_amdgcn_s_barrier()
#define PG8_SCHED __builtin_amdgcn_sched_barrier(0)
    Unit cur, nxt; int ui = 0;
    if (!S.next(0, cur)) return;
    f32x4 acc[2][2][4][2];
#pragma unroll
    for (int a = 0; a < 2; ++a)
#pragma unroll
        for (int b = 0; b < 2; ++b)
#pragma unroll
            for (int m = 0; m < 4; ++m)
#pragma unroll
                for (int n = 0; n < 2; ++n) acc[a][b][m][n] = (f32x4){0.f, 0.f, 0.f, 0.f};
    bf16x8 At[4][2], B0[2][2], B1[2][2];
    const char* cA = (const char*)g.A + (size_t)cur.pm * tstep; const char* cB = (const char*)g.Bt + (size_t)cur.pn * tstep;
    S.a_ready(cur);
    if constexpr (SP2) {
        PG8_STAGE(PG8_SB(0, 0), cB, voffB); PG8_STAGE(PG8_SB(0, 1), cB + hstep, voffB); PG8_STAGEA(PG8_SA(0, 0), cA, voffA); PG8_STAGEA(PG8_SA(0, 1), cA + hstep, voffA);
        if (wr == 1) PG8_BAR;
        PG8_WAIT_V(2); PG8_BAR;
        PG8_STAGE(PG8_SB(1, 0), cB + kstep, voffB); PG8_STAGEA(PG8_SA(1, 0), cA + kstep, voffA); PG8_STAGE(PG8_SB(1, 1), cB + hstep + kstep, voffB);
        PG8_WAIT_V(6); PG8_BAR;
    } else {
        PG8_STAGE(PG8_SB(0, 0), cB, voffB); PG8_STAGEA(PG8_SA(0, 0), cA, voffA); PG8_STAGE(PG8_SB(0, 1), cB + hstep, voffB); PG8_STAGEA(PG8_SA(0, 1), cA + hstep, voffA);
        if (wr == 1) PG8_BAR;
        PG8_WAIT_V(4); PG8_BAR;
        PG8_STAGE(PG8_SB(1, 0), cB + kstep, voffB); PG8_STAGEA(PG8_SA(1, 0), cA + kstep, voffA); PG8_STAGE(PG8_SB(1, 1), cB + hstep + kstep, voffB);
        PG8_WAIT_V(6); PG8_BAR;
    }
    for (;;) {
        const bool has_next = S.next(ui + 1, nxt);
        const char* nA = has_next ? (const char*)g.A + (size_t)nxt.pm * tstep : cA; const char* nB = has_next ? (const char*)g.Bt + (size_t)nxt.pn * tstep : cB;
        for (int t = 0; t < nt; t += 2) {
            const bool last = (t == nt - 2);
            const char* a1 = cA + (size_t)(t + 1) * kstep;
            const char* a2 = last ? nA : cA + (size_t)(t + 2) * kstep; const char* b2 = last ? nB : cB + (size_t)(t + 2) * kstep;
            const char* a3 = a2 + kstep; const char* b3 = b2 + kstep;
            if (last && has_next) S.a_ready(nxt);
            if constexpr (SP2) {
            PG8_LDB(B0, 0, 0); PG8_LDB(B1, 0, 1); PG8_SCHED; PG8_LDA(At, 0, 0); PG8_STAGEA(PG8_SA(1, 1), a1 + hstep, voffA);
            PG8_WAIT_V(8); PG8_WAIT_L(0); PG8_BAR; PG8_MMA(0, 0, At, B0); PG8_MMA(0, 1, At, B1); PG8_BAR; PG8_SCHED;
            PG8_LDA(At, 0, 1); PG8_STAGE(PG8_SB(0, 0), b2, voffB); PG8_STAGE(PG8_SB(0, 1), b2 + hstep, voffB); PG8_STAGEA(PG8_SA(0, 0), a2, voffA);
            PG8_WAIT_V(8); PG8_WAIT_L(0); PG8_BAR; PG8_MMA(1, 0, At, B0); PG8_MMA(1, 1, At, B1); PG8_BAR; PG8_SCHED;
            PG8_LDB(B0, 1, 0); PG8_LDB(B1, 1, 1); PG8_SCHED; PG8_LDA(At, 1, 0); PG8_STAGEA(PG8_SA(0, 1), a2 + hstep, voffA);
            PG8_WAIT_V(8); PG8_WAIT_L(0); PG8_BAR; PG8_MMA(0, 0, At, B0); PG8_MMA(0, 1, At, B1); PG8_BAR; PG8_SCHED;
            PG8_LDA(At, 1, 1); PG8_STAGE(PG8_SB(1, 0), b3, voffB); PG8_STAGE(PG8_SB(1, 1), b3 + hstep, voffB); PG8_STAGEA(PG8_SA(1, 0), a3, voffA);
            PG8_WAIT_V(8); PG8_WAIT_L(0); PG8_BAR; PG8_MMA(1, 0, At, B0); PG8_MMA(1, 1, At, B1); PG8_BAR; PG8_SCHED;
            } else {
            PG8_LDB(B0, 0, 0); PG8_SCHED; PG8_LDA(At, 0, 0); PG8_STAGEA(PG8_SA(1, 1), a1 + hstep, voffA);
            PG8_WAIT_L(8); PG8_BAR; PG8_WAIT_L(0); PG8_MMA(0, 0, At, B0); PG8_BAR; PG8_SCHED;
            PG8_LDB(B1, 0, 1); PG8_STAGE(PG8_SB(0, 0), b2, voffB);
            PG8_BAR; PG8_WAIT_L(0); PG8_MMA(0, 1, At, B1); PG8_BAR;
            PG8_LDA(At, 0, 1); PG8_STAGEA(PG8_SA(0, 0), a2, voffA);
            PG8_BAR; PG8_WAIT_L(0); PG8_MMA(1, 0, At, B0); PG8_BAR; PG8_SCHED;
            PG8_STAGE(PG8_SB(0, 1), b2 + hstep, voffB);
            PG8_WAIT_V(6); PG8_BAR; PG8_MMA(1, 1, At, B1); PG8_BAR;
            PG8_LDB(B0, 1, 0); PG8_SCHED; PG8_LDA(At, 1, 0); PG8_STAGEA(PG8_SA(0, 1), a2 + hstep, voffA);
            PG8_WAIT_L(8); PG8_BAR; PG8_WAIT_L(0); PG8_MMA(0, 0, At, B0); PG8_BAR; PG8_SCHED;
            PG8_LDB(B1, 1, 1); PG8_STAGE(PG8_SB(1, 0), b3, voffB);
            PG8_BAR; PG8_WAIT_L(0); PG8_MMA(0, 1, At, B1); PG8_BAR;
            PG8_LDA(At, 1, 1); PG8_STAGEA(PG8_SA(1, 0), a3, voffA);
            PG8_BAR; PG8_WAIT_L(0); PG8_MMA(1, 0, At, B0); PG8_BAR; PG8_SCHED;
            PG8_STAGE(PG8_SB(1, 1), b3 + hstep, voffB);
            PG8_WAIT_V(6); PG8_BAR; PG8_MMA(1, 1, At, B1); PG8_BAR;
            }
        }
        if constexpr (ALIGN_EPI) { if (wr == 0) PG8_BAR; }
        if constexpr (!Epi::AFTER_DRAIN) { E(acc, cur, wr, wc, fr, fq); S.done(cur); }
        if (!has_next) break;
#pragma unroll
        for (int a = 0; a < 2; ++a)
#pragma unroll
            for (int b = 0; b < 2; ++b)
#pragma unroll
                for (int m = 0; m < 4; ++m)
#pragma unroll
                    for (int n = 0; n < 2; ++n) acc[a][b][m][n] = (f32x4){0.f, 0.f, 0.f, 0.f};
        cur = nxt; cA = nA; cB = nB; ++ui;
        if constexpr (ALIGN_EPI) { if (wr == 1) PG8_BAR; }
    }
    PG8_WAIT_V(0);
    if constexpr (!ALIGN_EPI) { if (wr == 0) PG8_BAR; }
    PG8_BAR;
    if constexpr (Epi::AFTER_DRAIN) { E.fused(acc, cur, wr, wc, fr, fq, lds, wid, lane); S.done(cur); }
#undef PG8_SA
#undef PG8_SB
#undef PG8_STAGE
#undef PG8_STAGEA
#undef PG8_LDA
#undef PG8_LDB
#undef PG8_MMA
#undef PG8_WAIT_V
#undef PG8_WAIT_L
#undef PG8_BAR
#undef PG8_SCHED
}
}
namespace att {
using bf16 = unsigned short;
using bf16x8 = __attribute__((ext_vector_type(8))) short;
using s16x4  = __attribute__((ext_vector_type(4))) short;
using f32x16 = __attribute__((ext_vector_type(16))) float;
using u32x4  = __attribute__((ext_vector_type(4))) unsigned;
constexpr int KVBLK = 64;
constexpr size_t SHM_V = KVBLK * 128 * 2, SHM_K = KVBLK * 128 * 2;
constexpr size_t SHM_SCR = 2 * SHM_V + 2 * SHM_K;
constexpr size_t SHM_ATTN = SHM_SCR + 8 * 64 * 4;
constexpr float THR = 8.f;
#define KSWZ(row, colB) ((row) * 256 + ((colB) ^ (((row) & 7) << 4)))
#define SBAR() __builtin_amdgcn_sched_barrier(0)
__device__ __forceinline__ int crow(int r, int hi) { return (r & 3) + 8 * (r >> 2) + 4 * hi; }
__device__ __forceinline__ unsigned cvtpk(float lo, float hi) { unsigned r; asm volatile("v_cvt_pk_bf16_f32 %0, %1, %2" : "=v"(r) : "v"(lo), "v"(hi)); return r; }
__device__ __forceinline__ float max3f(float a, float b, float c) { return __builtin_fmaxf(__builtin_fmaxf(a, b), c); }
__device__ __forceinline__ float bf2f(unsigned short b) { return __uint_as_float(((unsigned)b) << 16); }

constexpr float THRL = 8.f;
template <bool MASK, bool FIRST>
__device__ __forceinline__ void partialSM(f32x16& p0, f32x16& p1, float& mhat, f32x16& negm, float& alpha, int mb, int hi) {
  if (MASK) {
#pragma unroll
    for (int r = 0; r < 16; ++r) { const int d = mb + crow(r, hi) + 128;
      if ((unsigned)d > 256u) p0[r] = -INFINITY; if ((unsigned)(d + 32) > 256u) p1[r] = -INFINITY; }
  }
  float pmax;
  { float a = max3f(p0[0], p0[1], p1[0]), b = max3f(p0[2], p0[3], p1[1]); a = max3f(a, p1[2], p1[3]);
#pragma unroll
    for (int r = 4; r < 16; r += 4) { a = max3f(a, p0[r], p0[r + 1]); b = max3f(b, p0[r + 2], p0[r + 3]); a = max3f(a, p1[r], p1[r + 1]); b = max3f(b, p1[r + 2], p1[r + 3]); }
    pmax = fmaxf(a, b); }
  { float pmax2 = pmax; asm volatile("" : "+v"(pmax2));
    auto rr = __builtin_amdgcn_permlane32_swap(__float_as_uint(pmax), __float_as_uint(pmax2), false, false);
    pmax = fmaxf(__uint_as_float(rr[0]), __uint_as_float(rr[1])); }
  alpha = 1.f;
  if (FIRST || !__builtin_expect(__all(pmax <= THRL), 1)) {
    const float dl = FIRST ? pmax : fmaxf(pmax, 0.f);
    mhat += dl;
#pragma unroll
    for (int r = 0; r < 16; ++r) { p0[r] -= dl; p1[r] -= dl; }
#pragma unroll
    for (int r = 0; r < 16; ++r) negm[r] = -mhat;
    asm volatile("" : "+v"(negm));
    alpha = __builtin_amdgcn_exp2f(-dl);
  }
#pragma unroll
  for (int r = 0; r < 16; ++r) p0[r] = __builtin_amdgcn_exp2f(p0[r]);
}
__device__ __forceinline__ void finishSM(f32x16& p0, f32x16& p1, float alpha, float& l_reg, bf16x8& pa0, bf16x8& pa1, bf16x8& pa2, bf16x8& pa3) {
#pragma unroll
  for (int r = 0; r < 16; ++r) p1[r] = __builtin_amdgcn_exp2f(p1[r]);
  float ps = 0;
#pragma unroll
  for (int r = 0; r < 16; ++r) ps += p0[r];
#pragma unroll
  for (int r = 0; r < 16; ++r) ps += p1[r];
  { float ps2 = ps; asm volatile("" : "+v"(ps2));
    auto rr = __builtin_amdgcn_permlane32_swap(__float_as_uint(ps), __float_as_uint(ps2), false, false);
    ps = __uint_as_float(rr[0]) + __uint_as_float(rr[1]); }
  l_reg = l_reg * alpha + ps;
#define PK4(P, BASE, OUT) do { u32x4 w = {cvtpk(P[BASE + 0], P[BASE + 1]), cvtpk(P[BASE + 2], P[BASE + 3]), cvtpk(P[BASE + 4], P[BASE + 5]), cvtpk(P[BASE + 6], P[BASE + 7])}; \
    OUT = *reinterpret_cast<bf16x8*>(&w); } while (0)
  PK4(p0, 0, pa0); PK4(p0, 8, pa1); PK4(p1, 0, pa2); PK4(p1, 8, pa3);
#undef PK4
}
template <int ND0>
__device__ __forceinline__ void qkt(f32x16& p0, f32x16& p1, const char* Ks, const bf16x8* qr, const f32x16& negm, int r32, int hi, int kb0) {
#pragma unroll
  for (int d0 = 0; d0 < ND0; ++d0) { const int cb = ((kb0 + d0) * 16 + hi * 8) * 2;
    bf16x8 b0 = *reinterpret_cast<const bf16x8*>(Ks + KSWZ(r32, cb));
    bf16x8 b1 = *reinterpret_cast<const bf16x8*>(Ks + KSWZ(32 + r32, cb));
    if (d0 == 0) { p0 = __builtin_amdgcn_mfma_f32_32x32x16_bf16(b0, qr[0], negm, 0, 0, 0); p1 = __builtin_amdgcn_mfma_f32_32x32x16_bf16(b1, qr[0], negm, 0, 0, 0); }
    else { p0 = __builtin_amdgcn_mfma_f32_32x32x16_bf16(b0, qr[d0], p0, 0, 0, 0); p1 = __builtin_amdgcn_mfma_f32_32x32x16_bf16(b1, qr[d0], p1, 0, 0, 0); } }
}
__device__ __forceinline__ int v_st(int k, int c) { const int kk = k; return ((kk >> 3) * 4 + (c >> 5)) * 512 + ((kk & 7) * 32 + (c & 31)) * 2; }
__device__ __forceinline__ int v_rd_base(int lane) { return ((lane & 3) << 3) | (((lane >> 2) & 3) << 6) | (((lane >> 4) & 1) << 5) | (((lane >> 5) & 1) << 8); }
constexpr int v_rd_off(int d0, int ks, int half) { return d0 * 512 + ks * 4096 + half * 2048; }
template <int OFF> __device__ __forceinline__ s16x4 tr_read(int vb) {
  s16x4 r; asm volatile("ds_read_b64_tr_b16 %0, %1 offset:%2" : "=&v"(r) : "v"(vb), "i"(OFF) : "memory"); return r;
}
template <int D0> __device__ __forceinline__ void pv_one(f32x16& od, int vb, bf16x8 pa0, bf16x8 pa1, bf16x8 pa2, bf16x8 pa3) {
  const s16x4 l0 = tr_read<v_rd_off(D0, 0, 0)>(vb), h0 = tr_read<v_rd_off(D0, 0, 1)>(vb), l1 = tr_read<v_rd_off(D0, 1, 0)>(vb), h1 = tr_read<v_rd_off(D0, 1, 1)>(vb);
  const s16x4 l2 = tr_read<v_rd_off(D0, 2, 0)>(vb), h2 = tr_read<v_rd_off(D0, 2, 1)>(vb), l3 = tr_read<v_rd_off(D0, 3, 0)>(vb), h3 = tr_read<v_rd_off(D0, 3, 1)>(vb);
  asm volatile("s_waitcnt lgkmcnt(0)" ::: "memory"); SBAR();
#define PK(L, H) (bf16x8){L[0], L[1], L[2], L[3], H[0], H[1], H[2], H[3]}
  od = __builtin_amdgcn_mfma_f32_32x32x16_bf16(pa0, PK(l0, h0), od, 0, 0, 0);
  od = __builtin_amdgcn_mfma_f32_32x32x16_bf16(pa1, PK(l1, h1), od, 0, 0, 0);
  od = __builtin_amdgcn_mfma_f32_32x32x16_bf16(pa2, PK(l2, h2), od, 0, 0, 0);
  od = __builtin_amdgcn_mfma_f32_32x32x16_bf16(pa3, PK(l3, h3), od, 0, 0, 0);
#undef PK
}
__device__ __forceinline__ void pv_d0(f32x16* o, int vb, bf16x8 pa0, bf16x8 pa1, bf16x8 pa2, bf16x8 pa3) {
  pv_one<0>(o[0], vb, pa0, pa1, pa2, pa3); pv_one<1>(o[1], vb, pa0, pa1, pa2, pa3); pv_one<2>(o[2], vb, pa0, pa1, pa2, pa3); pv_one<3>(o[3], vb, pa0, pa1, pa2, pa3);
}

template <int ND0, bool MASK, int SDEPTH, bool FIRSTREF, bool SKIP>
__device__ __forceinline__ void attn_core(const bf16x8* qr, const bf16* __restrict__ Kt, const bf16* __restrict__ Vt, const long ld, const int NT, const int mb0, const int kb0,
                                          float mhat, float& l_reg, f32x16 (&o)[4], char* lds, const int wv) {
  const int tid = opaque_tid(wv), wid = tid >> 6, lane = tid & 63, r32 = lane & 31, hi = lane >> 5;
  char* V_lds = lds; char* K_lds = lds + 2 * SHM_V;
  float* al_l = (float*)(lds + SHM_SCR) + wid * 64 + 32;
  const int sr = tid >> 4, sc = (tid & 15) * 8, vst0 = v_st(sr, sc), vst1 = v_st(32 + sr, sc);
  const int vb0 = (int)(uintptr_t)V_lds + v_rd_base(lane);
  const int wrel = (MASK && SKIP) ? __builtin_amdgcn_readfirstlane(mb0 + r32) : 0;
#define ACT(t) (!(MASK && SKIP) || (unsigned)(wrel + 64 * (t) + 191) <= 350u)
  struct { bf16x8 vs0, vs1, ks0, ks1; } sr_[SDEPTH];
#define SLOAD(i, k0) do { sr_[i].vs0 = *(const bf16x8*)(Vt + (long)(k0) * ld); sr_[i].vs1 = *(const bf16x8*)(Vt + (long)((k0) + 32) * ld); \
    sr_[i].ks0 = *(const bf16x8*)(Kt + (long)(k0) * ld); sr_[i].ks1 = *(const bf16x8*)(Kt + (long)((k0) + 32) * ld); } while (0)
#define SWRITE(b, i) do { *(bf16x8*)(V_lds + (b) * SHM_V + vst0) = sr_[i].vs0; *(bf16x8*)(V_lds + (b) * SHM_V + vst1) = sr_[i].vs1; const int kc = sc * 2; \
    *(bf16x8*)(K_lds + (b) * SHM_K + KSWZ(sr, kc)) = sr_[i].ks0; *(bf16x8*)(K_lds + (b) * SHM_K + KSWZ(32 + sr, kc)) = sr_[i].ks1; } while (0)
#define SWAIT() do { if constexpr (SDEPTH == 2) asm volatile("s_waitcnt vmcnt(4)" ::: "memory"); else asm volatile("s_waitcnt vmcnt(0)" ::: "memory"); } while (0)
#define RESC(a) do { if (__any((a) < 1.f)) { if (hi == 0) al_l[r32] = (a); asm volatile("s_waitcnt lgkmcnt(0)" ::: "memory"); \
    _Pragma("unroll") for (int d = 0; d < 4; ++d) _Pragma("unroll") for (int r = 0; r < 16; ++r) o[d][r] *= al_l[crow(r, hi)]; } } while (0)
  f32x16 pA0, pA1, pB0, pB1; float alA = 1.f, alB = 1.f; bf16x8 pa0, pa1, pa2, pa3;
  f32x16 negm;
#pragma unroll
  for (int r = 0; r < 16; ++r) negm[r] = -mhat;
  asm volatile("" : "+v"(negm));
  constexpr int SE = 0, SO = SDEPTH - 1;
  bool aA = ACT(0), aB = false;
  SLOAD(SE, 0); asm volatile("s_waitcnt vmcnt(0)" ::: "memory"); SWRITE(0, SE); __syncthreads();
  if (aA) { qkt<ND0>(pA0, pA1, K_lds, qr, negm, r32, hi, kb0); partialSM<MASK, FIRSTREF>(pA0, pA1, mhat, negm, alA, mb0, hi); }
  SLOAD(SO, KVBLK); if constexpr (SDEPTH == 2) { if (2 < NT) SLOAD(SE, 2 * KVBLK); }
  SWAIT(); SWRITE(1, SO); __syncthreads();
  for (int j = 1; j + 1 < NT; j += 2) {
    aB = ACT(j);
    SBAR(); if (aB) qkt<ND0>(pB0, pB1, K_lds + SHM_K, qr, negm, r32, hi, kb0);
    if (aA) finishSM(pA0, pA1, alA, l_reg, pa0, pa1, pa2, pa3); SBAR();
    SLOAD(SO, (j + SDEPTH) * KVBLK); SBAR();
    if (aA) pv_d0(o, vb0, pa0, pa1, pa2, pa3);
    alB = 1.f; if (aB) partialSM<MASK, false>(pB0, pB1, mhat, negm, alB, mb0 + j * KVBLK, hi);
    __syncthreads(); SWAIT(); SWRITE(0, SE);
    RESC(alB); __syncthreads();
    aA = ACT(j + 1);
    SBAR(); if (aA) qkt<ND0>(pA0, pA1, K_lds, qr, negm, r32, hi, kb0);
    if (aB) finishSM(pB0, pB1, alB, l_reg, pa0, pa1, pa2, pa3); SBAR();
    if (SDEPTH == 1 || j + 3 < NT) SLOAD(SE, (j + 1 + SDEPTH) * KVBLK); SBAR();
    if (aB) pv_d0(o, vb0 + (int)SHM_V, pa0, pa1, pa2, pa3);
    alA = 1.f; if (aA) partialSM<MASK, false>(pA0, pA1, mhat, negm, alA, mb0 + (j + 1) * KVBLK, hi);
    __syncthreads(); SWAIT(); SWRITE(1, SO);
    RESC(alA); __syncthreads();
  }
  aB = ACT(NT - 1);
  SBAR(); if (aB) qkt<ND0>(pB0, pB1, K_lds + SHM_K, qr, negm, r32, hi, kb0);
  if (aA) finishSM(pA0, pA1, alA, l_reg, pa0, pa1, pa2, pa3); SBAR();
  if (aA) pv_d0(o, vb0, pa0, pa1, pa2, pa3);
  alB = 1.f; if (aB) partialSM<MASK, false>(pB0, pB1, mhat, negm, alB, mb0 + (NT - 1) * KVBLK, hi);
  __syncthreads(); RESC(alB);
  if (aB) { finishSM(pB0, pB1, alB, l_reg, pa0, pa1, pa2, pa3); SBAR();
    pv_d0(o, vb0 + (int)SHM_V, pa0, pa1, pa2, pa3); }
#undef ACT
#undef SLOAD
#undef SWRITE
#undef SWAIT
#undef RESC
}

constexpr size_t RING_SCR = 6 * 16384;
template <int ND0, bool MASK, bool FIRSTREF>
__device__ __forceinline__ void attn_core_ring(const bf16x8* qr, const char* __restrict__ zb, const unsigned offK, const unsigned offV, const long ld, const int NT, const int mb0, const int kb0,
                                               float mhat, float& l_reg, f32x16 (&o)[4], char* lds, const int wv) {
  const int tid = opaque_tid(wv), wid = tid >> 6, lane = tid & 63, r32 = lane & 31, hi = lane >> 5;
  char* V_lds = lds; char* K_lds = lds + 3 * 16384;
  float* al_l = (float*)(lds + RING_SCR) + wid * 64 + 32;
  const int sr = tid >> 4, sc = (tid & 15) * 8, vst0 = v_st(sr, sc), kst0 = KSWZ(sr, sc * 2);
  const int vb0 = (int)(uintptr_t)V_lds + v_rd_base(lane);
  bf16x8 svs0, svs1, sks0, sks1;
#define SLOAD(k0) do { const char* b0_ = zb + (long)(k0) * (ld * 2); const char* b1_ = b0_ + 32 * (ld * 2);                   \
    unsigned ov_ = offV, ok_ = offK; asm volatile("" : "+v"(ov_), "+v"(ok_));     \
    svs0 = *(const bf16x8*)(b0_ + ov_); svs1 = *(const bf16x8*)(b1_ + ov_); sks0 = *(const bf16x8*)(b0_ + ok_); sks1 = *(const bf16x8*)(b1_ + ok_); } while (0)
#define SWRITE(off) do { char* vw_ = V_lds + (off) + vst0; *(bf16x8*)vw_ = svs0; *(bf16x8*)(vw_ + 8192) = svs1;              \
    char* kw_ = K_lds + (off) + kst0; *(bf16x8*)kw_ = sks0; *(bf16x8*)(kw_ + 8192) = sks1; } while (0)
#define RESC(a) do { if (__any((a) < 1.f)) { if (hi == 0) al_l[r32] = (a); asm volatile("s_waitcnt lgkmcnt(0)" ::: "memory"); \
    _Pragma("unroll") for (int d = 0; d < 4; ++d) _Pragma("unroll") for (int r = 0; r < 16; ++r) o[d][r] *= al_l[crow(r, hi)]; } } while (0)
#define LBAR() asm volatile("s_waitcnt lgkmcnt(0)\n\ts_barrier" ::: "memory")
#define ROT() do { const int t_ = prv; prv = cur; cur = nxt; nxt = t_; } while (0)
  f32x16 pA0, pA1, pB0, pB1; float alA, alB; bf16x8 pa0, pa1, pa2, pa3;
  f32x16 negm;
#pragma unroll
  for (int r = 0; r < 16; ++r) negm[r] = -mhat;
  asm volatile("" : "+v"(negm));
  int prv = 2 * 16384, cur = 0, nxt = 16384;
  SLOAD(0); asm volatile("s_waitcnt vmcnt(0)" ::: "memory"); SWRITE(0); SLOAD(KVBLK);
  __syncthreads();
  qkt<ND0>(pA0, pA1, K_lds + cur, qr, negm, r32, hi, kb0);
  SWRITE(nxt); if (2 < NT) SLOAD(2 * KVBLK);
  partialSM<MASK, FIRSTREF>(pA0, pA1, mhat, negm, alA, mb0, hi);
  ROT();
  for (int j = 1; j + 1 < NT; j += 2) {
    LBAR();
    SBAR(); qkt<ND0>(pB0, pB1, K_lds + cur, qr, negm, r32, hi, kb0);
    SWRITE(nxt); if (j + 2 < NT) SLOAD((j + 2) * KVBLK); SBAR();
    finishSM(pA0, pA1, alA, l_reg, pa0, pa1, pa2, pa3); SBAR();
    pv_d0(o, vb0 + prv, pa0, pa1, pa2, pa3); partialSM<MASK, false>(pB0, pB1, mhat, negm, alB, mb0 + j * KVBLK, hi);
    RESC(alB); ROT();
    LBAR();
    SBAR(); qkt<ND0>(pA0, pA1, K_lds + cur, qr, negm, r32, hi, kb0);
    SWRITE(nxt); if (j + 3 < NT) SLOAD((j + 3) * KVBLK); SBAR();
    finishSM(pB0, pB1, alB, l_reg, pa0, pa1, pa2, pa3); SBAR();
    pv_d0(o, vb0 + prv, pa0, pa1, pa2, pa3); partialSM<MASK, false>(pA0, pA1, mhat, negm, alA, mb0 + (j + 1) * KVBLK, hi);
    RESC(alA); ROT();
  }
  LBAR();
  SBAR(); qkt<ND0>(pB0, pB1, K_lds + cur, qr, negm, r32, hi, kb0);
  finishSM(pA0, pA1, alA, l_reg, pa0, pa1, pa2, pa3); SBAR();
  pv_d0(o, vb0 + prv, pa0, pa1, pa2, pa3); partialSM<MASK, false>(pB0, pB1, mhat, negm, alB, mb0 + (NT - 1) * KVBLK, hi);
  RESC(alB);
  finishSM(pB0, pB1, alB, l_reg, pa0, pa1, pa2, pa3); SBAR();
  pv_d0(o, vb0 + cur, pa0, pa1, pa2, pa3);
  __syncthreads();
#undef SLOAD
#undef SWRITE
#undef RESC
#undef ROT
#undef LBAR
}
}
constexpr int DM = 2048, NTOK = 32768  , DEPTH = 4, AB_IN = 5120, C_INW = 3072, DFF = 8192;
constexpr float EPS = 1e-6f;
constexpr size_t MiB = 1u << 20;
constexpr size_t WS_CTL = 0, CTL_ZERO_BYTES = 1 * MiB;
constexpr size_t WS_TABB = 1 * MiB, WS_TABC = 2 * MiB, WS_MISC = 4 * MiB, WS_R2 = 5 * MiB;
constexpr size_t WS_WINAB = 8 * MiB, WS_WOUTAB = 48 * MiB, WS_WINC = 64 * MiB, WS_WOUTC = 88 * MiB, WS_WUP = 104 * MiB, WS_WDOWN = 232 * MiB;
constexpr size_t WS_H = 360 * MiB, WS_Z = 488 * MiB, WS_CAT = 808 * MiB, WS_HID = 488 * MiB, WS_OUT = 1000 * MiB, WS_END = 1128 * MiB;
static_assert(WS_WINAB + 2ull * AB_IN * DM * 2 <= WS_WOUTAB && WS_WOUTAB + 2ull * DM * DM * 2 <= WS_WINC && WS_WINC + 2ull * C_INW * DM * 2 <= WS_WOUTC && WS_WOUTC + 2ull * DM * DM * 2 <= WS_WUP &&
              WS_WUP + 4ull * DFF * DM * 2 <= WS_WDOWN && WS_WDOWN + 4ull * DFF * DM * 2 <= WS_H && WS_H + (size_t)NTOK * DM * 2 <= WS_Z && WS_Z + (size_t)NTOK * AB_IN * 2 <= WS_CAT &&
              WS_CAT + (size_t)NTOK * DM * 2 <= WS_OUT && WS_HID + (size_t)NTOK * DFF * 2 <= WS_OUT && WS_OUT + (size_t)NTOK * DM * 2 <= WS_END, "d_ws map");
constexpr int CW_BAR = 4096;
constexpr int NWAVES = 8;
constexpr int LDS_BYTES = 147456, RING_BYTES = 131072, MISC_OFF = RING_BYTES + 320;

#define GAS __attribute__((address_space(1)))
#define LAS __attribute__((address_space(3)))
typedef unsigned short bf16;
typedef unsigned v4u __attribute__((ext_vector_type(4)));
typedef unsigned v2u __attribute__((ext_vector_type(2)));
typedef float f32x4 __attribute__((ext_vector_type(4)));
typedef short bf16x8 __attribute__((ext_vector_type(8)));
typedef GAS unsigned gu32;
#define RLX_AGENT __ATOMIC_RELAXED, __HIP_MEMORY_SCOPE_AGENT
#define LDS_WAIT() asm volatile("s_waitcnt lgkmcnt(0)" ::: "memory")
__device__ __forceinline__ unsigned f2bf(float f) { unsigned u = __builtin_bit_cast(unsigned, f); return (u + 0x7fffu + ((u >> 16) & 1u)) >> 16; }
__device__ __forceinline__ unsigned pk2(float lo, float hi) { return f2bf(lo) | (f2bf(hi) << 16); }
__device__ __forceinline__ float bflo(unsigned w) { return __uint_as_float(w << 16); }
__device__ __forceinline__ float bfhi(unsigned w) { return __uint_as_float(w & 0xffff0000u); }

#define XB_TMO      128
#define XB_XCNT(j)  (256  + 64 * (j))
#define XB_XSUB(j)  (1280 + 64 * (j))
#define XB_XGEN(j)  (2304 + 64 * (j))
#define XB_TOP      3328
#define XB_TOPGEN   3392
#define XCD_BAR_WORDS 3456
#define XB_SPIN_CAP (1u << 18)

__device__ __forceinline__ unsigned xb_ld(unsigned* p)              { return __hip_atomic_load(p, __ATOMIC_RELAXED, __HIP_MEMORY_SCOPE_AGENT); }
__device__ __forceinline__ unsigned xb_add(unsigned* p, unsigned v) { return __hip_atomic_fetch_add(p, v, __ATOMIC_RELAXED, __HIP_MEMORY_SCOPE_AGENT); }
__device__ __forceinline__ unsigned xb_xcc_id() { return (unsigned)__builtin_amdgcn_s_getreg((3 << 11) | 20) & 0xFu; }
#define XB_SPIN(cond, bar) do { unsigned _sp = 0; while (cond) { __builtin_amdgcn_s_sleep(1); \
    if ((++_sp & 255u) == 0u) { if (xb_ld(&(bar)[XB_TMO])) break; if (_sp > XB_SPIN_CAP) { atomicAdd(&(bar)[XB_TMO], 1u); break; } } } } while (0)

struct XcdBarrier {
    unsigned* bar; unsigned x; unsigned wv;
    volatile LAS unsigned* st;
};

__device__ __forceinline__ XcdBarrier xcd_barrier_post(unsigned* bar, volatile LAS unsigned* st) {
    XcdBarrier b; b.bar = bar; b.x = xb_xcc_id(); b.st = st; b.wv = (unsigned)__builtin_amdgcn_readfirstlane(threadIdx.x >> 6);
    if (threadIdx.x == 0) (void)xb_add(&bar[XB_XCNT(b.x)], 1u);
    return b;
}
__device__ __forceinline__ void xcd_barrier_complete(unsigned* bar, unsigned x, unsigned& nloc, unsigned& nx) {
    const unsigned G = gridDim.x * gridDim.y * gridDim.z;
    unsigned sum, cnt, mine, sp = 0u;
    for (;;) {
        sum = 0u; cnt = 0u; mine = 0u;
#pragma unroll
        for (unsigned j = 0; j < 16; ++j) { const unsigned c = xb_ld(&bar[XB_XCNT(j)]); sum += c; cnt += (c > 0u) ? 1u : 0u; mine = (j == x) ? c : mine; }
        if (sum == G) break;
        __builtin_amdgcn_s_sleep(1);
        if ((++sp & 255u) == 0u) { if (xb_ld(&bar[XB_TMO])) break; if (sp > XB_SPIN_CAP) { atomicAdd(&bar[XB_TMO], 1u); break; } }
    }
    nloc = mine > 0u ? mine : 1u; nx = cnt > 0u ? cnt : 1u;
}

__device__ __forceinline__ void xcd_barrier(const XcdBarrier& b) {
    asm volatile("s_waitcnt vmcnt(0)" ::: "memory");
    __syncthreads();
    if (b.wv == 0u && __builtin_amdgcn_mbcnt_hi(~0u, __builtin_amdgcn_mbcnt_lo(~0u, 0u)) == 0u) {
        unsigned* bar = b.bar; unsigned bx = b.x; asm volatile("" : "+s"(bx));
        __builtin_amdgcn_s_waitcnt(0);
        unsigned nloc = b.st[0], nx = b.st[1];
        if (nloc == 0u) { xcd_barrier_complete(bar, bx, nloc, nx); b.st[0] = nloc; b.st[1] = nx; }
        const unsigned old = xb_add(&bar[XB_XSUB(bx)], 1u);
        const unsigned gen = old / nloc;
        if (old + 1u == (gen + 1u) * nloc) {
            __builtin_amdgcn_fence(__ATOMIC_RELEASE, "agent");
            asm volatile("s_waitcnt vmcnt(0)" ::: "memory");
            const unsigned og = xb_add(&bar[XB_TOP], 1u);
            const unsigned tg = og / nx;
            if (og + 1u == (tg + 1u) * nx) xb_add(&bar[XB_TOPGEN], 1u);
            else XB_SPIN(xb_ld(&bar[XB_TOPGEN]) == tg, bar);
            __builtin_amdgcn_fence(__ATOMIC_ACQUIRE, "agent");
            xb_add(&bar[XB_XGEN(bx)], 1u);
            asm volatile("s_waitcnt vmcnt(0)" ::: "memory");
        } else {
            XB_SPIN(xb_ld(&bar[XB_XGEN(bx)]) == gen, bar);
            __builtin_amdgcn_fence(__ATOMIC_ACQUIRE, "agent");
            asm volatile("s_waitcnt vmcnt(0)" ::: "memory");
        }
    }
    __syncthreads();
}
__device__ const double ROPE_INV[16] = { 1.0, 0.44036660267178046, 0.19392274474868576, 0.08539710028576561, 0.03760603093086393, 0.016560440080994446, 0.007292664737217109,
    0.003211445994752591, 0.001414213562373095, 0.000622772421914596, 0.0002742481756762073, 0.00012076973741146504, 5.318295896944988e-05, 2.341999896140934e-05,
    1.031338537721246e-05, 4.5416704806078695e-06 };
__device__ __forceinline__ void sincos_d(double a, float& s, float& c) {
    const double k = rint(a * 0.63661977236758134308);
    double y = fma(-k, 1.57079632679489655800e+00, a); y = fma(-k, 6.12323399573676603587e-17, y);
    const double y2 = y * y;
    double sp = -7.647163731819816e-13; sp = fma(sp, y2, 1.6059043836821613e-10); sp = fma(sp, y2, -2.505210838544172e-08); sp = fma(sp, y2, 2.7557319223985893e-06);
    sp = fma(sp, y2, -1.984126984126984e-04); sp = fma(sp, y2, 8.333333333333333e-03); sp = fma(sp, y2, -1.6666666666666666e-01); sp = fma(sp * y2, y, y);
    double cp = 4.779477332387385e-14; cp = fma(cp, y2, -1.1470745597729725e-11); cp = fma(cp, y2, 2.08767569878681e-09); cp = fma(cp, y2, -2.755731922398589e-07);
    cp = fma(cp, y2, 2.48015873015873e-05); cp = fma(cp, y2, -1.388888888888889e-03); cp = fma(cp, y2, 4.1666666666666664e-02); cp = fma(cp, y2, -0.5); cp = fma(cp, y2, 1.0);
    const int q = ((int)((long long)k)) & 3;
    const double ss = (q & 1) ? cp : sp, cc = (q & 1) ? sp : cp;
    s = (float)((q & 2) ? -ss : ss); c = (float)(((q + 1) & 2) ? -cc : cc);
}
__device__ __forceinline__ float wave_sum(float v) {
    v = xor_add<1>(v); v = xor_add<2>(v); v = xor_add<4>(v); v = xor_add<8>(v); v = xor_add<16>(v); v = xor_add<32>(v);
    return v;
}
__device__ __forceinline__ void p0_transpose_item(const float* W, int K, int N, bf16* WT, LAS float* scr, int item, int lane, const float* gk) {
    const int nblk = N / 32, kb = item / nblk, nb = item % nblk, k0 = 64 * kb, n0 = 32 * nb;
#pragma unroll 8
    for (int i = 0; i < 32; ++i) { const int kk = 2 * i + (lane >> 5); scr[kk * 33 + (lane & 31)] = W[(size_t)(k0 + kk) * N + n0 + (lane & 31)] * (gk ? gk[k0 + kk] : 1.f); }
    LDS_WAIT(); asm volatile("" ::: "memory");
    const int c = lane & 7;
#pragma unroll
    for (int j = 0; j < 4; ++j) { const int n = (lane >> 3) + 8 * j; const LAS float* s = scr + (8 * c) * 33 + n;
        v4u o; o.x = pk2(s[0 * 33], s[1 * 33]); o.y = pk2(s[2 * 33], s[3 * 33]); o.z = pk2(s[4 * 33], s[5 * 33]); o.w = pk2(s[6 * 33], s[7 * 33]);
        *(GAS v4u*)(WT + (size_t)(n0 + n) * K + k0 + 8 * c) = o; }
    LDS_WAIT(); asm volatile("" ::: "memory");
}

struct Args { const float* in[18]; float* out; unsigned char* ws; int ph_lo, ph_hi; };

__device__ __forceinline__ void prologue(const Args& a, LAS unsigned char* lds, int gw, int NGW, int lane, int wave) {
    unsigned char* ws = a.ws;
    LAS float* scr = (LAS float*)(lds + wave * 16384);
    constexpr int I0 = 32 * 160, I1 = 32 * 64, I2 = 32 * 96, I3 = 32 * 64, I4 = 32 * 256, I5 = 128 * 64;
    constexpr int NITEMS = 2 * I0 + 2 * I1 + 2 * I2 + 2 * I3 + 4 * I4 + 4 * I5;
    for (int it = gw; it < NITEMS; it += NGW) {
        int r = it;
        if (r < 2 * I0) { const int j = r / I0; p0_transpose_item(a.in[6] + (size_t)j * DM * AB_IN, DM, AB_IN, (bf16*)(ws + WS_WINAB) + (size_t)j * AB_IN * DM, scr, r % I0, lane, a.in[2] + (2 * j) * DM); continue; } r -= 2 * I0;
        if (r < 2 * I1) { const int j = r / I1; p0_transpose_item(a.in[7] + (size_t)j * DM * DM, DM, DM, (bf16*)(ws + WS_WOUTAB) + (size_t)j * DM * DM, scr, r % I1, lane, nullptr); continue; } r -= 2 * I1;
        if (r < 2 * I2) { const int j = r / I2; p0_transpose_item(a.in[13] + (size_t)j * DM * C_INW, DM, C_INW, (bf16*)(ws + WS_WINC) + (size_t)j * C_INW * DM, scr, r % I2, lane, a.in[2] + (2 * j + 1) * DM); continue; } r -= 2 * I2;
        if (r < 2 * I3) { const int j = r / I3; p0_transpose_item(a.in[14] + (size_t)j * DM * DM, DM, DM, (bf16*)(ws + WS_WOUTC) + (size_t)j * DM * DM, scr, r % I3, lane, nullptr); continue; } r -= 2 * I3;
        if (r < 4 * I4) { const int j = r / I4; p0_transpose_item(a.in[16] + (size_t)j * DM * DFF, DM, DFF, (bf16*)(ws + WS_WUP) + (size_t)j * DFF * DM, scr, r % I4, lane, a.in[4] + j * DM); continue; } r -= 4 * I4;
        { const int j = r / I5; p0_transpose_item(a.in[17] + (size_t)j * DFF * DM, DFF, DM, (bf16*)(ws + WS_WDOWN) + (size_t)j * DM * DFF, scr, r % I5, lane, nullptr); }
    }
    float* tabB = (float*)(ws + WS_TABB); float* tabC = (float*)(ws + WS_TABC);
    for (int e = gw * 64 + lane; e < 16384 * 24; e += NGW * 64) {
        if (e < 16384 * 8) { const int pos = e >> 3, j = e & 7; float s, c; sincos_d((double)pos * ROPE_INV[2 * j], s, c); tabB[pos * 16 + j] = c; tabB[pos * 16 + 8 + j] = s; }
        else { const int e2 = e - 16384 * 8, pos = e2 >> 4, j = e2 & 15; float s, c; sincos_d((double)pos * ROPE_INV[j], s, c); tabC[pos * 32 + j] = c; tabC[pos * 32 + 16 + j] = s; }
    }
    if (gw == 0 && lane < 2) {
        const float* lv = a.in[11] + lane * 256; float d0 = 0.f, d1 = 0.f;
        for (int i = 0; i < 64; ++i) { d0 += lv[i] * lv[64 + i]; d1 += lv[128 + i] * lv[192 + i]; }
        const float li = lane == 0 ? 0.2f : 0.4707130183435842f;
        float* misc = (float*)(ws + WS_MISC);
        misc[lane] = __builtin_amdgcn_exp2f(d0 * 1.4426950408889634f) - __builtin_amdgcn_exp2f(d1 * 1.4426950408889634f) + li;
        misc[2 + lane] = 1.0f - li;
    }
}

template <int MODE, int RB>
__device__ __forceinline__ void rowpass(const float* xin, float* xout, bf16* XB, const bf16* OUT, const float* gpost, float* R2, int gw, int NGW, int lane) {
    f32x4 gp[4][2];
    if (MODE != 0) {
#pragma unroll
        for (int k = 0; k < 4; ++k) { gp[k][0] = *(const f32x4*)(gpost + 512 * k + 8 * lane); gp[k][1] = *(const f32x4*)(gpost + 512 * k + 8 * lane + 4); }
    }
    for (int row0 = gw * RB; row0 < NTOK; row0 += NGW * RB) {
        v4u xw[RB][4], ow[RB][4]; f32x4 xf[RB][4][2];
#pragma unroll
        for (int rb = 0; rb < RB; ++rb) {
            const int row = row0 + rb;
            if (MODE == 0) {
                const GAS f32x4* xr = (const GAS f32x4*)(xin + (size_t)row * DM) + 2 * lane;
#pragma unroll
                for (int k = 0; k < 4; ++k) { xf[rb][k][0] = xr[128 * k]; xf[rb][k][1] = xr[128 * k + 1]; }
            } else {
                const GAS v4u* xr = (const GAS v4u*)(XB + (size_t)row * DM) + lane;
                const GAS v4u* orow = (const GAS v4u*)(OUT + (size_t)row * DM) + lane;
#pragma unroll
                for (int k = 0; k < 4; ++k) { xw[rb][k] = __builtin_nontemporal_load(xr + 64 * k); ow[rb][k] = __builtin_nontemporal_load(orow + 64 * k); }
            }
        }
#pragma unroll
        for (int rb = 0; rb < RB; ++rb) {
            const int row = row0 + rb;
            f32x4 x[4][2];
            if (MODE == 0) {
#pragma unroll
                for (int k = 0; k < 4; ++k) { x[k][0] = xf[rb][k][0]; x[k][1] = xf[rb][k][1]; }
            } else {
                f32x4 o[4][2]; float ss = 0.f;
#pragma unroll
                for (int k = 0; k < 4; ++k) { const v4u w = ow[rb][k]; o[k][0] = (f32x4){bflo(w.x), bfhi(w.x), bflo(w.y), bfhi(w.y)}; o[k][1] = (f32x4){bflo(w.z), bfhi(w.z), bflo(w.w), bfhi(w.w)};
#pragma unroll
                    for (int h = 0; h < 2; ++h) ss += (o[k][h].x * o[k][h].x + o[k][h].y * o[k][h].y) + (o[k][h].z * o[k][h].z + o[k][h].w * o[k][h].w); }
                const float r1 = 1.0f / sqrtf(wave_sum(ss) * (1.0f / DM) + EPS);
#pragma unroll
                for (int k = 0; k < 4; ++k) { const v4u w = xw[rb][k];
                    x[k][0] = (f32x4){bflo(w.x), bfhi(w.x), bflo(w.y), bfhi(w.y)} + (o[k][0] * r1) * gp[k][0];
                    x[k][1] = (f32x4){bflo(w.z), bfhi(w.z), bflo(w.w), bfhi(w.w)} + (o[k][1] * r1) * gp[k][1]; }
            }
            if (MODE == 2) {
                GAS f32x4* xo = (GAS f32x4*)(xout + (size_t)row * DM) + 2 * lane;
#pragma unroll
                for (int k = 0; k < 4; ++k) { xo[128 * k] = x[k][0]; xo[128 * k + 1] = x[k][1]; }
            } else {
                float s2 = 0.f;
#pragma unroll
                for (int k = 0; k < 4; ++k)
#pragma unroll
                    for (int h = 0; h < 2; ++h) s2 += (x[k][h].x * x[k][h].x + x[k][h].y * x[k][h].y) + (x[k][h].z * x[k][h].z + x[k][h].w * x[k][h].w);
                const float r2 = 1.0f / sqrtf(wave_sum(s2) * (1.0f / DM) + EPS);
                if (lane == 0) R2[row] = r2;
                GAS v4u* xo = (GAS v4u*)(XB + (size_t)row * DM) + lane;
#pragma unroll
                for (int k = 0; k < 4; ++k) { v4u w; w.x = pk2(x[k][0].x, x[k][0].y); w.y = pk2(x[k][0].z, x[k][0].w); w.z = pk2(x[k][1].x, x[k][1].y); w.w = pk2(x[k][1].z, x[k][1].w); xo[64 * k] = w; }
            }
        }
    }
}

__device__ __forceinline__ void gmlp_unit(const bf16* Zc, bf16* CATc, int g, const float* wsg, const float* bsg, const float* vng, char* lds, const int wv) {
    using att::f32x16;
    const int tid = opaque_tid(wv), wid = tid >> 6, lane = tid & 63, r32 = lane & 31, hi = lane >> 5;
    bf16* vT = (bf16*)lds; float* mx = (float*)(lds + 36864);
    const int row = tid >> 2, cq = (tid & 3) * 8;
    {
        const bf16* vp = Zc + (size_t)row * AB_IN + 1024 + g * 128 + cq;
        float v[32]; float ss = 0.f;
#pragma unroll
        for (int i = 0; i < 4; ++i) { const v4u w = *(const v4u*)(vp + 32 * i);
            v[8 * i + 0] = bflo(w.x); v[8 * i + 1] = bfhi(w.x); v[8 * i + 2] = bflo(w.y); v[8 * i + 3] = bfhi(w.y); v[8 * i + 4] = bflo(w.z); v[8 * i + 5] = bfhi(w.z); v[8 * i + 6] = bflo(w.w); v[8 * i + 7] = bfhi(w.w); }
#pragma unroll
        for (int i = 0; i < 32; ++i) ss += v[i] * v[i];
        ss = xor_add<1>(ss); ss = xor_add<2>(ss);
        const float rn = 1.0f / sqrtf(ss * (1.0f / 128.0f) + EPS);
        const int qrot = (row + 16 * (tid & 3)) & 127;
#pragma unroll
        for (int i = 0; i < 4; ++i) { const f32x4 g0 = *(const f32x4*)(vng + 32 * i + cq), g1 = *(const f32x4*)(vng + 32 * i + cq + 4);
#pragma unroll
            for (int e2 = 0; e2 < 8; ++e2) vT[(32 * i + cq + e2) * 136 + qrot] = (bf16)f2bf(v[8 * i + e2] * rn * (e2 < 4 ? g0[e2 & 3] : g1[e2 & 3])); }
    }
    __syncthreads();
    const int pb = wid & 3, ch = wid >> 2;
    f32x16 acc[2] = {};
    const float* wrow = wsg + (32 * pb + r32) * 128 + 8 * hi;
    const int frot = 16 * ((r32 >> 3) & 3);
#pragma unroll
    for (int ks = 0; ks < 8; ++ks) {
        const f32x4 a0 = *(const f32x4*)(wrow + 16 * ks), a1 = *(const f32x4*)(wrow + 16 * ks + 4);
        v4u aw = {att::cvtpk(a0.x, a0.y), att::cvtpk(a0.z, a0.w), att::cvtpk(a1.x, a1.y), att::cvtpk(a1.z, a1.w)};
        const bf16x8 A = *reinterpret_cast<bf16x8*>(&aw);
#pragma unroll
        for (int cb = 0; cb < 2; ++cb) { const bf16x8 B = *(const bf16x8*)((const char*)vT + ((64 * ch + 32 * cb + r32) * 136 + ((16 * ks + 8 * hi + frot) & 127)) * 2);
            acc[cb] = __builtin_amdgcn_mfma_f32_32x32x16_bf16(A, B, acc[cb], 0, 0, 0); }
    }
#pragma unroll
    for (int r = 0; r < 16; ++r) { const int p = 32 * pb + att::crow(r, hi); const float bias = bsg[p];
#pragma unroll
        for (int cb = 0; cb < 2; ++cb) mx[p * 132 + 64 * ch + 32 * cb + r32] = acc[cb][r] + bias; }
    __syncthreads();
    {
        const bf16* up = Zc + (size_t)row * AB_IN + g * 128 + cq; bf16* op = CATc + (size_t)row * DM + g * 128 + cq;
#pragma unroll
        for (int i = 0; i < 4; ++i) { const v4u w = *(const v4u*)(up + 32 * i);
            const f32x4 m0 = *(const f32x4*)(mx + row * 132 + 32 * i + cq), m1 = *(const f32x4*)(mx + row * 132 + 32 * i + cq + 4);
            v4u o; o.x = pk2(bflo(w.x) * m0.x, bfhi(w.x) * m0.y); o.y = pk2(bflo(w.y) * m0.z, bfhi(w.y) * m0.w); o.z = pk2(bflo(w.z) * m1.x, bfhi(w.z) * m1.y); o.w = pk2(bflo(w.w) * m1.z, bfhi(w.w) * m1.w);
            *(v4u*)(op + 32 * i) = o; }
    }
    __syncthreads();
}

#define O_STAGE_STORE(VAL, stg, dst, ldd) do { \
    _Pragma("unroll") for (int r = 0; r < 16; ++r) { const int orow_ = att::crow(r, hi); \
        _Pragma("unroll") for (int d0 = 0; d0 < 4; ++d0) (stg)[orow_ * 136 + d0 * 32 + r32] = (bf16)f2bf(VAL(d0, r)); } \
    asm volatile("s_waitcnt lgkmcnt(0)" ::: "memory"); \
    _Pragma("unroll") for (int i_ = 0; i_ < 8; ++i_) { const int pi_ = i_ * 64 + lane, prow_ = pi_ >> 4, pch_ = pi_ & 15; \
        const v4u w_ = *(const v4u*)((stg) + prow_ * 136 + pch_ * 8); *(v4u*)((dst) + (long)prow_ * (ldd) + pch_ * 8) = w_; } \
    asm volatile("s_waitcnt lgkmcnt(0)" ::: "memory"); } while (0)

__device__ __forceinline__ void diff_attn_unit(const bf16* Zs, bf16* CATs, int S, int h, int qb, float lam, float oscale, const float* subg, char* lds, const int wv) {
    using namespace att;
    const int tid = opaque_tid(wv), wid = tid >> 6, lane = tid & 63, r32 = lane & 31, hi = lane >> 5, br = wid >> 2, wq = wid & 3;
    const long ld = AB_IN;
    const bf16* Qw = Zs + (long)(qb * 128 + wq * 32 + r32) * ld + 2048 + (br * 8 + h) * 64 + hi * 8;
    bf16x8 qr[4];
#pragma unroll
    for (int d0 = 0; d0 < 4; ++d0) qr[d0] = *(const bf16x8*)(Qw + d0 * 16);
    const int sr = tid >> 4, sc = (tid & 15) * 8;
    const unsigned offK = (unsigned)((sr * AB_IN + 3072 + h * 64 + (sc < 64 ? sc : 448 + sc)) * 2), offV = (unsigned)((sr * AB_IN + 4096 + h * 128 + sc) * 2);
    f32x16 o[4] = {}; float l = 0.f;
    attn_core_ring<4, false, true>(qr, (const char*)Zs, offK, offV, ld, S / 64, 0, br * 4, 0.f, l, o, lds, wv);
    float* li_l = (float*)(lds + RING_SCR) + wid * 64;
    if (hi == 0) li_l[r32] = l;
    asm volatile("s_waitcnt lgkmcnt(0)" ::: "memory");
    float rli[16];
#pragma unroll
    for (int r = 0; r < 16; ++r) rli[r] = __builtin_amdgcn_rcpf(li_l[crow(r, hi)]);
    __syncthreads();
    float* cbuf = (float*)lds + wq * 4096;
    if (br == 1) {
#pragma unroll
        for (int d0 = 0; d0 < 4; ++d0)
#pragma unroll
            for (int r = 0; r < 16; ++r) cbuf[(d0 * 16 + r) * 64 + lane] = o[d0][r] * rli[r];
    }
    __syncthreads();
    if (br == 0) {
        float g4[4];
#pragma unroll
        for (int d0 = 0; d0 < 4; ++d0) g4[d0] = subg[d0 * 32 + r32] * oscale;
        float rn[16];
#pragma unroll
        for (int r = 0; r < 16; ++r) {
            float ss = 0.f;
#pragma unroll
            for (int d0 = 0; d0 < 4; ++d0) { const float v = o[d0][r] * rli[r] - lam * cbuf[(d0 * 16 + r) * 64 + lane]; o[d0][r] = v; ss += v * v; }
            ss = xor_add<1>(ss); ss = xor_add<2>(ss); ss = xor_add<4>(ss); ss = xor_add<8>(ss); ss = xor_add<16>(ss);
            rn[r] = 1.0f / sqrtf(ss * (1.0f / 128.0f) + EPS);
        }
        asm volatile("s_waitcnt lgkmcnt(0)" ::: "memory");
        bf16* stg = (bf16*)cbuf; bf16* dst = CATs + (long)(qb * 128 + wq * 32) * DM + 1024 + h * 128;
#define DVAL(d0, r) (o[d0][r] * rn[r] * g4[d0])
        O_STAGE_STORE(DVAL, stg, dst, DM);
#undef DVAL
    }
    __syncthreads();
}

#ifndef WIN_SKIP
#define WIN_SKIP false
#endif
__device__ __forceinline__ void win_attn_unit(const bf16* Zs, bf16* CATs, int S, int hp, int qb, const float* sinks, char* lds, const int wv) {
    using namespace att;
    const int tid = opaque_tid(wv), wid = tid >> 6, lane = tid & 63, r32 = lane & 31, hi = lane >> 5;
    const long ld = C_INW; const int hq = 2 * hp + (wid >> 2), kvh = hp >> 1, q0 = qb * 128, qw = q0 + (wid & 3) * 32;
    const int klo = q0 - 128 < 0 ? 0 : q0 - 128, khi = q0 + 256 > S ? S : q0 + 256, NT = (khi - klo) / 64;
    const bf16* Qw = Zs + (long)(qw + r32) * ld + hq * 128 + hi * 8;
    bf16x8 qr[8];
#pragma unroll
    for (int d0 = 0; d0 < 8; ++d0) qr[d0] = *(const bf16x8*)(Qw + d0 * 16);
    const int sr = tid >> 4, sc = (tid & 15) * 8;
    const bf16* Kt = Zs + (long)(klo + sr) * ld + 2048 + kvh * 128 + sc;
    const bf16* Vt = Zs + (long)(klo + sr) * ld + 2560 + kvh * 128 + sc;
    f32x16 o[4] = {}; float l = 1.f;
    attn_core<8, true, 1, false, WIN_SKIP>(qr, Kt, Vt, ld, NT, klo - (qw + r32), 0, sinks[hq] * 1.4426950408889634f, l, o, lds, wv);
    float* li_l = (float*)(lds + SHM_SCR) + wid * 64;
    if (hi == 0) li_l[r32] = l;
    asm volatile("s_waitcnt lgkmcnt(0)" ::: "memory");
    float rl[16];
#pragma unroll
    for (int r = 0; r < 16; ++r) rl[r] = __builtin_amdgcn_rcpf(li_l[crow(r, hi)]);
    __syncthreads();
    { bf16* stg = (bf16*)(lds + wid * 8704); bf16* dst = CATs + (long)qw * DM + hq * 128;
#define WVAL(d0, r) (o[d0][r] * rl[r])
      O_STAGE_STORE(WVAL, stg, dst, DM);
#undef WVAL
    }
    __syncthreads();
}
#ifndef REP0
#define REP0 1
#endif
#ifndef REP1
#define REP1 1
#endif
#ifndef REP2
#define REP2 1
#endif
#ifndef REP3
#define REP3 1
#endif
#ifndef REP4
#define REP4 1
#endif
#ifndef REP5
#define REP5 1
#endif
#ifndef REP6
#define REP6 1
#endif
#ifndef REP7
#define REP7 1
#endif
#ifndef REP8
#define REP8 1
#endif
#ifndef REP9
#define REP9 1
#endif
#ifndef REP10
#define REP10 1
#endif
#ifndef PHASE_MASK
#define PHASE_MASK 0xFFFF
#endif
#ifndef MK_SPLIT
#define MK_SPLIT 0
#endif
constexpr int N_PHASES = 1 + 2 * (1 + 4 * 7);
__global__ void __launch_bounds__(NWAVES * 64, 2) fwd_kernel(Args a) {
    extern __shared__ __attribute__((aligned(16))) unsigned char lds[];
    LAS unsigned char* L = (LAS unsigned char*)lds;
    const int tid = threadIdx.x, wave = __builtin_amdgcn_readfirstlane(tid >> 6);
    const int G = gridDim.x, c = blockIdx.x;
    volatile LAS unsigned* MISC = (volatile LAS unsigned*)(L + MISC_OFF);
    for (int u = tid; u < (LDS_BYTES - RING_BYTES) / 4; u += NWAVES * 64) ((LAS unsigned*)(L + RING_BYTES))[u] = 0u;
    __syncthreads();
    unsigned char* ws0 = a.ws;
#define KARG ({ const __attribute__((address_space(4))) Args* p_ = (const __attribute__((address_space(4))) Args*)__builtin_amdgcn_kernarg_segment_ptr(); asm volatile("" : "+s"(p_)); p_; })
#define ws ({ GAS unsigned char* w_ = (GAS unsigned char*)ws0; asm volatile("" : "+s"(w_)); (unsigned char*)w_; })
#define AIN(k) ((const float*)(const GAS float*)KARG->in[k])
    unsigned* ctl = (unsigned*)(ws0 + WS_CTL);
    XcdBarrier bar = xcd_barrier_post(ctl + CW_BAR, MISC + 8);
#define IN() true
#define SEAM() xcd_barrier(bar)
    const int gw = c * NWAVES + wave, NGW = G * NWAVES;
    const bool x8 = (G & 7) == 0; const int xcd = c & 7, xr = c >> 3, xper = G >> 3;
#define H ((bf16*)(ws + WS_H))
#define R2 ((float*)(ws + WS_R2))
#define Z ((bf16*)(ws + WS_Z))
#define CAT ((bf16*)(ws + WS_CAT))
#define HID ((bf16*)(ws + WS_HID))
#define OUT ((bf16*)(ws + WS_OUT))
#define tabB ((const float*)(ws + WS_TABB))
#define tabC ((const float*)(ws + WS_TABC))
#define misc ((const float*)(ws + WS_MISC))

    if (IN() && ((PHASE_MASK >> 0) & 1)) { for (int rep_ = 0; rep_ < REP0; ++rep_) { prologue(a, L, gw, NGW, (opaque_tid(wave) & 63), wave); } SEAM(); }

    for (int grp = 0; grp < 2; ++grp) {
        const int S = grp ? 16384 : 2048, smask = S - 1;
        if (IN() && ((PHASE_MASK >> 1) & 1)) { for (int rep_ = 0; rep_ < REP1; ++rep_) { rowpass<0, 2>(AIN(grp), nullptr, H, nullptr, nullptr, R2, gw, NGW, (opaque_tid(wave) & 63)); } SEAM(); }
        for (int l = 0; l < DEPTH; ++l) {
            const int j = l >> 1;
            if ((l & 1) == 0) {
                if (IN() && ((PHASE_MASK >> 2) & 1)) { for (int rep_ = 0; rep_ < REP2; ++rep_) {
                    pg8::Gemm g{H, (const bf16*)(ws + WS_WINAB) + (size_t)j * AB_IN * DM, NTOK, AB_IN, DM}; pg8::StaticOrder So; So.init(NTOK, AB_IN, G, c, 8);
                    pg8::EpiAct<2> E{Z, AB_IN, tabB, smask, R2};
                    pg8::gemm_phase<pg8::EpiAct<2>, pg8::StaticOrder, true, true>(L, g, So, E, wave);
                    } SEAM(); }
                if (IN() && ((PHASE_MASK >> 3) & 1)) { for (int rep_ = 0; rep_ < REP3; ++rep_) {
                    if ((PHASE_MASK >> 11) & 1) { const int U = (NTOK / 128) * 8; const int u0 = x8 ? xcd * (U / 8) + xr : c, u1 = x8 ? (xcd + 1) * (U / 8) : U, us = x8 ? xper : G;
                      for (int u = u0; u < u1; u += us) { const int chunk = u >> 3, g = u & 7;
                          gmlp_unit(Z + (size_t)chunk * 128 * AB_IN, CAT + (size_t)chunk * 128 * DM, g, AIN(9) + (size_t)(j * 8 + g) * 16384, AIN(10) + (j * 8 + g) * 128, AIN(8) + (j * 8 + g) * 128, (char*)lds, wave); } }
                    if ((PHASE_MASK >> 12) & 1) { const float lam = misc[j], osc = misc[2 + j]; const float* subg = AIN(12) + j * 128;
                      const int nqb = S / 128, U = (NTOK / 128) * 8; const int u0 = x8 ? xcd * (U / 8) + xr : c, u1 = x8 ? (xcd + 1) * (U / 8) : U, us = x8 ? xper : G;
                      for (int u = u0; u < u1; u += us) { const int pair = u / nqb, qb = u % nqb, b = pair >> 3, h = pair & 7;
                          diff_attn_unit(Z + (size_t)b * S * AB_IN, CAT + (size_t)b * S * DM, S, h, qb, lam, osc, subg, (char*)lds, wave); } }
                    } SEAM(); }
            } else {
                if (IN() && ((PHASE_MASK >> 4) & 1)) { for (int rep_ = 0; rep_ < REP4; ++rep_) {
                    pg8::Gemm g{H, (const bf16*)(ws + WS_WINC) + (size_t)j * C_INW * DM, NTOK, C_INW, DM}; pg8::StaticOrder So; So.init(NTOK, C_INW, G, c, 8);
                    pg8::EpiAct<3> E{Z, C_INW, tabC, smask, R2};
                    pg8::gemm_phase<pg8::EpiAct<3>, pg8::StaticOrder, true, true>(L, g, So, E, wave);
                    } SEAM(); }
                if (IN() && ((PHASE_MASK >> 5) & 1)) { for (int rep_ = 0; rep_ < REP5; ++rep_) {
                    const int nqb = S / 128, U = (NTOK / 128) * 8; const int u0 = x8 ? xcd * (U / 8) + xr : c, u1 = x8 ? (xcd + 1) * (U / 8) : U, us = x8 ? xper : G;
                    for (int u = u0; u < u1; u += us) { const int blk = u >> 3, hp = u & 7, b = blk / nqb, qb = blk % nqb;
                        win_attn_unit(Z + (size_t)b * S * C_INW, CAT + (size_t)b * S * DM, S, hp, qb, AIN(15) + j * 16, (char*)lds, wave); }
                    } SEAM(); }
            }
            if (IN() && ((PHASE_MASK >> 6) & 1)) { for (int rep_ = 0; rep_ < REP6; ++rep_) {
                const bf16* Wt = (l & 1) ? (const bf16*)(ws + WS_WOUTC) + (size_t)j * DM * DM : (const bf16*)(ws + WS_WOUTAB) + (size_t)j * DM * DM;
                pg8::Gemm g{CAT, Wt, NTOK, DM, DM}; pg8::StaticOrder So; So.init(NTOK, DM, G, c, 8);
                pg8::EpiAct<0> E{OUT, DM, nullptr, 0, nullptr};
                pg8::gemm_phase<pg8::EpiAct<0>, pg8::StaticOrder, true, true>(L, g, So, E, wave);
                } SEAM(); }
            if (IN() && ((PHASE_MASK >> 7) & 1)) { for (int rep_ = 0; rep_ < REP7; ++rep_) { rowpass<1, 4>(nullptr, nullptr, H, OUT, AIN(3) + l * DM, R2, gw, NGW, (opaque_tid(wave) & 63)); } SEAM(); }
            if (IN() && ((PHASE_MASK >> 8) & 1)) { for (int rep_ = 0; rep_ < REP8; ++rep_) {
                pg8::Gemm g{H, (const bf16*)(ws + WS_WUP) + (size_t)l * DFF * DM, NTOK, DFF, DM}; pg8::StaticOrder So; So.init(NTOK, DFF, G, c);
                pg8::EpiAct<1> E{HID, DFF, nullptr, 0, R2};
                pg8::gemm_phase<pg8::EpiAct<1>, pg8::StaticOrder, true, true>(L, g, So, E, wave);
                } SEAM(); }
            if (IN() && ((PHASE_MASK >> 9) & 1)) { for (int rep_ = 0; rep_ < REP9; ++rep_) {
                pg8::Gemm g{HID, (const bf16*)(ws + WS_WDOWN) + (size_t)l * DM * DFF, NTOK, DM, DFF}; pg8::StaticOrder So; So.init(NTOK, DM, G, c);
                pg8::EpiAct<0> E{OUT, DM, nullptr, 0, nullptr};
                pg8::gemm_phase<pg8::EpiAct<0>, pg8::StaticOrder, true, true>(L, g, So, E, wave);
                } SEAM(); }
            if (IN() && ((PHASE_MASK >> 10) & 1)) { for (int rep_ = 0; rep_ < REP10; ++rep_) { if (l + 1 < DEPTH) rowpass<1, 4>(nullptr, nullptr, H, OUT, AIN(5) + l * DM, R2, gw, NGW, (opaque_tid(wave) & 63)); else rowpass<2, 4>(nullptr, ((float*)(GAS float*)KARG->out) + (size_t)grp * NTOK * DM, H, OUT, AIN(5) + l * DM, nullptr, gw, NGW, (opaque_tid(wave) & 63)); } if (!(grp == 1 && l + 1 == DEPTH)) SEAM(); }
        }
    }
#undef IN
#undef SEAM
#undef ws
#undef KARG
#undef AIN
#undef H
#undef R2
#undef Z
#undef CAT
#undef HID
#undef OUT
#undef tabB
#undef tabC
#undef misc
}

extern "C" void kernel_launch(void* const* d_in, const int* in_sizes, int n_in, void* d_out, int out_size, void* d_ws, size_t ws_size, hipStream_t stream) {
    static int grid = 0;
    if (grid == 0) {
        if (n_in != 18 || in_sizes[0] != NTOK * DM || in_sizes[1] != NTOK * DM || out_size != 2 * NTOK * DM || ws_size < WS_END) {
            fprintf(stderr, "kernel_launch: unexpected shapes (n_in %d, in0 %d, out %d, ws %zu, need ws >= %zu); nothing launched\n", n_in, n_in > 0 ? in_sizes[0] : -1, out_size, ws_size, (size_t)WS_END); grid = -1; return; }
        int dev = 0, cus = 0;
        if (hipGetDevice(&dev) != hipSuccess || hipDeviceGetAttribute(&cus, hipDeviceAttributeMultiprocessorCount, dev) != hipSuccess) { grid = -1; return; }
        if (hipFuncSetAttribute((const void*)fwd_kernel, hipFuncAttributeMaxDynamicSharedMemorySize, LDS_BYTES) != hipSuccess) { fprintf(stderr, "kernel_launch: hipFuncSetAttribute failed\n"); grid = -1; return; }
        int per_cu = 0;
        if (hipOccupancyMaxActiveBlocksPerMultiprocessor(&per_cu, (const void*)fwd_kernel, NWAVES * 64, LDS_BYTES) != hipSuccess || per_cu < 1) { fprintf(stderr, "kernel_launch: occupancy query says %d blocks per CU\n", per_cu); }
        (void)hipGetLastError();
        grid = cus;
    }
    if (grid < 0) return;
    if (hipMemsetAsync((char*)d_ws + WS_CTL, 0, CTL_ZERO_BYTES, stream) != hipSuccess) return;
    Args a{};
    for (int i = 0; i < 18; ++i) a.in[i] = (const float*)d_in[i];
    a.out = (float*)d_out; a.ws = (unsigned char*)d_ws;
    a.ph_lo = 0; a.ph_hi = N_PHASES;
    hipLaunchKernelGGL(fwd_kernel, dim3(grid), dim3(NWAVES * 64), LDS_BYTES, stream, a);
    const hipError_t le = hipPeekAtLastError();
    if (le != hipSuccess) fprintf(stderr, "kernel_launch: launch failed: %s\n", hipGetErrorName(le));
}
```

```cpp
#include <hip/hip_runtime.h>
#include <hip/hip_bf16.h>
#include <cstdio>
#include <cstdint>
#include <cmath>
__device__ __forceinline__ int opaque_tid(int wv) { int t = (wv << 6) | (int)__builtin_amdgcn_mbcnt_hi(~0u, __builtin_amdgcn_mbcnt_lo(~0u, 0u)); asm volatile("" : "+v"(t)); return t; }
__device__ __forceinline__ int xor32_addr() { int a = (int)((__builtin_amdgcn_mbcnt_hi(~0u, __builtin_amdgcn_mbcnt_lo(~0u, 0u)) ^ 32u) << 2); asm volatile("" : "+v"(a)); return a; }
template <int K> __device__ __forceinline__ float xor_get(float v) {
    if constexpr (K < 32) return __builtin_bit_cast(float, __builtin_amdgcn_ds_swizzle(__builtin_bit_cast(int, v), (K << 10) | 0x1f));
    else return __builtin_bit_cast(float, __builtin_amdgcn_ds_bpermute(xor32_addr(), __builtin_bit_cast(int, v)));
}
template <int K> __device__ __forceinline__ float xor_add(float v) { return v + xor_get<K>(v); }
namespace pg8 {
#define PG8_LAS __attribute__((address_space(3)))
typedef unsigned short bf16_t;
typedef short bf16x8 __attribute__((ext_vector_type(8)));
typedef float f32x4 __attribute__((ext_vector_type(4)));
typedef unsigned u32x4 __attribute__((ext_vector_type(4)));
constexpr int BM = 256, BK = 64, HALF = 128, HTB = HALF * BK * 2  , STAGE_BYTES = 8 * HTB, NXCD = 8, WGM = 4;

__host__ __device__ __forceinline__ int lds_byte(int r, int c) { const int st = (r >> 4) * 2 + (c >> 5), rr = r & 15, cc = c & 31, ob = rr * 64 + cc * 2; return st * 1024 + (ob ^ (((ob >> 9) & 1) << 5)); }
__host__ __device__ __forceinline__ void stage_rc(int b, int& R, int& C) { const int st = b / 1024, sb = b % 1024, swz = sb ^ (((sb >> 9) & 1) << 5); R = (st >> 1) * 16 + swz / 64; C = (st & 1) * 32 + (swz % 64) / 2; }
__host__ __device__ __forceinline__ int perm32(int rho) { const int n = rho >> 4, i = rho & 15; return 8 * (i >> 2) + 4 * n + (i & 3); }

struct Unit { int pm, pn; };
struct Gemm { const bf16_t* A; const bf16_t* Bt; int M, N, K; };

struct StaticOrder {
    int nM, nN, nwg, G, c, wgm;
    __host__ __device__ void init(int M, int N, int G_, int c_, int wgm_ = WGM) { nM = M / BM; nN = N / BM; nwg = nM * nN; G = G_; c = c_; wgm = wgm_; }
    __host__ __device__ bool next(int i, Unit& u) const {
        const long L = (long)i * G + c; if (L >= nwg) return false;
        int wgid = (int)L; { const int q = nwg / NXCD, r = nwg % NXCD, xcd = wgid % NXCD, off = wgid / NXCD; wgid = (xcd < r ? xcd * (q + 1) : r * (q + 1) + (xcd - r) * q) + off; }
        const int nig = wgm * nN, gid = wgid / nig, fm = gid * wgm, gsz = (nM - fm) < wgm ? (nM - fm) : wgm;
        u.pm = fm + ((wgid % nig) % gsz); u.pn = (wgid % nig) / gsz; return true;
    }
    __device__ __forceinline__ void a_ready(const Unit&) const {}
    __device__ __forceinline__ void done(const Unit&) const {}
};

__device__ __forceinline__ unsigned cvt_pk_bf16(float lo, float hi) { unsigned r; asm volatile("v_cvt_pk_bf16_f32 %0, %1, %2" : "=v"(r) : "v"(lo), "v"(hi)); return r; }
typedef float f32x2 __attribute__((ext_vector_type(2)));
__device__ __forceinline__ float gelu_tanh(float x) {
    const float t = x * (2.3022082f + 0.10294324f * x * x);
    return x * __builtin_amdgcn_rcpf(1.0f + __builtin_amdgcn_exp2f(-t));
}
template <int MODE> struct EpiAct {
    static constexpr bool PERM = true, AFTER_DRAIN = false;
    bf16_t* O; int ldc; const float* tab; int smask; const float* rs;
    __device__ __forceinline__ void operator()(const f32x4 (&acc)[2][2][4][2], const Unit& u, int wr, int wc, int fr, int fq) const {
        const int row0 = u.pm * BM + wr * 64 + fr; const int colt = u.pn * BM;
        const int col0 = colt + wc * 32 + 8 * fq;
        int mode = 0;
        if (MODE == 1) mode = 1;
        if (MODE == 2) mode = colt < 2048 ? 2 : (colt < 4096 ? 3 : 0);
        if (MODE == 3) mode = colt < 2560 ? 4 : 0;
        const bool ropeB = (mode == 3) && ((wc & 1) == 0), ropeC = (mode == 4) && (wc == 0);
#pragma unroll
        for (int ai = 0; ai < 2; ++ai)
#pragma unroll
            for (int m = 0; m < 4; ++m) {
                const int row = row0 + ai * HALF + m * 16;
                bf16_t* rowp = O + (size_t)row * ldc + col0;
                const float rsc = (MODE != 0) ? rs[row] : 1.f;
                f32x4 c0 = {1.f, 1.f, 1.f, 1.f}, c1 = c0, s0 = {0.f, 0.f, 0.f, 0.f}, s1 = s0;
                if (MODE == 2) { if (ropeB) { const float* t = tab + (size_t)(row & smask) * 16; c0 = *(const f32x4*)t; c1 = *(const f32x4*)(t + 4); s0 = *(const f32x4*)(t + 8); s1 = *(const f32x4*)(t + 12); } }
                if (MODE == 3) { if (ropeC) { const float* t = tab + (size_t)(row & smask) * 32 + (fq & 1) * 8; c0 = *(const f32x4*)t; c1 = *(const f32x4*)(t + 4); s0 = *(const f32x4*)(t + 16); s1 = *(const f32x4*)(t + 20); } }
#pragma unroll
                for (int bj = 0; bj < 2; ++bj) {
                    f32x4 v0 = acc[ai][bj][m][0], v1 = acc[ai][bj][m][1];
                    if (MODE != 0) { v0 = v0 * rsc; v1 = v1 * rsc; }
                    if (MODE == 1) {
#pragma unroll
                        for (int j = 0; j < 4; ++j) { const float a = fmaxf(v0[j], 0.f), b = fmaxf(v1[j], 0.f); v0[j] = a * a; v1[j] = b * b; }
                    }
                    if (MODE == 2) {
                        if (mode == 2) {
#pragma unroll
                            for (int j = 0; j < 4; ++j) { v0[j] = gelu_tanh(v0[j]); v1[j] = gelu_tanh(v1[j]); }
                        }
                        if (ropeB) {
                            f32x4 o0, o1;
#pragma unroll
                            for (int j = 0; j < 4; ++j) { o0[j] = xor_get<16>(v0[j]); o1[j] = xor_get<16>(v1[j]); }
                            if (fq < 2) { const float sg = fq ? 1.f : -1.f; v0 = v0 * c0 + (o0 * s0) * sg; v1 = v1 * c1 + (o1 * s1) * sg; }
                        }
                    }
                    if (MODE == 3) {
                        if (ropeC) {
                            f32x4 o0, o1;
#pragma unroll
                            for (int j = 0; j < 4; ++j) { o0[j] = xor_get<32>(v0[j]); o1[j] = xor_get<32>(v1[j]); }
                            const float sg = (fq >= 2) ? 1.f : -1.f; v0 = v0 * c0 + (o0 * s0) * sg; v1 = v1 * c1 + (o1 * s1) * sg;
                        }
                    }
                    if (MODE == 2) { if (colt >= 2048 && colt < 3072) { v0 = v0 * 0.18033688011112042f; v1 = v1 * 0.18033688011112042f; } }
                    if (MODE == 3) { if (colt < 2048) { v0 = v0 * 0.12751743082459868f; v1 = v1 * 0.12751743082459868f; } }
                    u32x4 w; w.x = cvt_pk_bf16(v0[0], v0[1]); w.y = cvt_pk_bf16(v0[2], v0[3]); w.z = cvt_pk_bf16(v1[0], v1[1]); w.w = cvt_pk_bf16(v1[2], v1[3]);
                    if (MODE == 1) __builtin_nontemporal_store(w, (u32x4*)(rowp + bj * HALF));
                    else *(u32x4*)(rowp + bj * HALF) = w;
                }

            }
    }
};

template <class Epi, class Sched, bool ALIGN_EPI = false, bool SP2 = false, int AUXA = 0>
__device__ __forceinline__ void gemm_phase(PG8_LAS unsigned char* lds, const Gemm g, const Sched& S, const Epi& E, const int wv) {
    const int tid = opaque_tid(wv), wid = wv, lane = tid & 63, wr = wid >> 2, wc = wid & 3, fr = lane & 15, fq = lane >> 4;
    const int K = g.K, nt = K / BK;
    unsigned voffA[2], voffB[2];
#pragma unroll
    for (int i = 0; i < 2; ++i) { int R, C; stage_rc(tid * 16 + i * 8192, R, C); const int Rb = Epi::PERM ? ((R & ~31) + perm32(R & 31)) : R;
        voffA[i] = (unsigned)(R * K + C) * 2u; voffB[i] = (unsigned)(Rb * K + C) * 2u; }
    const size_t kstep = (size_t)(BK * 2);
    const size_t hstep = (size_t)HALF * K * 2;
    const size_t tstep = 2 * hstep;
    const unsigned ldsw = (unsigned)wid * 1024u;
    const int aoff = lds_byte(wr * 64 + fr, fq * 8), boff = lds_byte(wc * 32 + fr, fq * 8);
#define PG8_SA(b, h) (((b) * 2 + (h)) * HTB)
#define PG8_SB(b, h) ((4 + (b) * 2 + (h)) * HTB)
#define PG8_STAGE(bufoff, gbase, voff) do { _Pragma("unroll") for (int _i = 0; _i < 2; ++_i) \
        __builtin_amdgcn_global_load_lds((const unsigned*)((const char*)(gbase) + (voff)[_i]), (PG8_LAS unsigned*)(lds + (bufoff) + ldsw + _i * 8192), 16, 0, 0); } while (0)
#define PG8_STAGEA(bufoff, gbase, voff) do { _Pragma("unroll") for (int _i = 0; _i < 2; ++_i) \
        __builtin_amdgcn_global_load_lds((const unsigned*)((const char*)(gbase) + (voff)[_i]), (PG8_LAS unsigned*)(lds + (bufoff) + ldsw + _i * 8192), 16, 0, AUXA); } while (0)
#define PG8_LDA(dst, b, h) do { _Pragma("unroll") for (int m = 0; m < 4; ++m) _Pragma("unroll") for (int k = 0; k < 2; ++k) dst[m][k] = *(const PG8_LAS bf16x8*)(lds + PG8_SA(b, h) + aoff + m * 2048 + k * 1024); } while (0)
#define PG8_LDB(dst, b, h) do { _Pragma("unroll") for (int n = 0; n < 2; ++n) _Pragma("unroll") for (int k = 0; k < 2; ++k) dst[n][k] = *(const PG8_LAS bf16x8*)(lds + PG8_SB(b, h) + boff + n * 2048 + k * 1024); } while (0)
#define PG8_MMA(ai, bj, At, Bt) do { __builtin_amdgcn_s_setprio(1); _Pragma("unroll") for (int m = 0; m < 4; ++m) _Pragma("unroll") for (int n = 0; n < 2; ++n) _Pragma("unroll") for (int k = 0; k < 2; ++k) \
        acc[ai][bj][m][n] = __builtin_amdgcn_mfma_f32_16x16x32_bf16(Bt[n][k], At[m][k], acc[ai][bj][m][n], 0, 0, 0); __builtin_amdgcn_s_setprio(0); } while (0)
#define PG8_WAIT_V(n) asm volatile("s_waitcnt vmcnt(" #n ")" ::: "memory")
#define PG8_WAIT_L(n) asm volatile("s_waitcnt lgkmcnt(" #n ")" ::: "memory")
#define PG8_BAR __builtin_amdgcn_s_barrier()
#define PG8_SCHED __builtin_amdgcn_sched_barrier(0)
    Unit cur, nxt; int ui = 0;
    if (!S.next(0, cur)) return;
    f32x4 acc[2][2][4][2];
#pragma unroll
    for (int a = 0; a < 2; ++a)
#pragma unroll
        for (int b = 0; b < 2; ++b)
#pragma unroll
            for (int m = 0; m < 4; ++m)
#pragma unroll
                for (int n = 0; n < 2; ++n) acc[a][b][m][n] = (f32x4){0.f, 0.f, 0.f, 0.f};
    bf16x8 At[4][2], B0[2][2], B1[2][2];
    const char* cA = (const char*)g.A + (size_t)cur.pm * tstep; const char* cB = (const char*)g.Bt + (size_t)cur.pn * tstep;
    S.a_ready(cur);
    if constexpr (SP2) {
        PG8_STAGE(PG8_SB(0, 0), cB, voffB); PG8_STAGE(PG8_SB(0, 1), cB + hstep, voffB); PG8_STAGEA(PG8_SA(0, 0), cA, voffA); PG8_STAGEA(PG8_SA(0, 1), cA + hstep, voffA);
        if (wr == 1) PG8_BAR;
        PG8_WAIT_V(2); PG8_BAR;
        PG8_STAGE(PG8_SB(1, 0), cB + kstep, voffB); PG8_STAGEA(PG8_SA(1, 0), cA + kstep, voffA); PG8_STAGE(PG8_SB(1, 1), cB + hstep + kstep, voffB);
        PG8_WAIT_V(6); PG8_BAR;
    } else {
        PG8_STAGE(PG8_SB(0, 0), cB, voffB); PG8_STAGEA(PG8_SA(0, 0), cA, voffA); PG8_STAGE(PG8_SB(0, 1), cB + hstep, voffB); PG8_STAGEA(PG8_SA(0, 1), cA + hstep, voffA);
        if (wr == 1) PG8_BAR;
        PG8_WAIT_V(4); PG8_BAR;
        PG8_STAGE(PG8_SB(1, 0), cB + kstep, voffB); PG8_STAGEA(PG8_SA(1, 0), cA + kstep, voffA); PG8_STAGE(PG8_SB(1, 1), cB + hstep + kstep, voffB);
        PG8_WAIT_V(6); PG8_BAR;
    }
    for (;;) {
        const bool has_next = S.next(ui + 1, nxt);
        const char* nA = has_next ? (const char*)g.A + (size_t)nxt.pm * tstep : cA; const char* nB = has_next ? (const char*)g.Bt + (size_t)nxt.pn * tstep : cB;
        for (int t = 0; t < nt; t += 2) {
            const bool last = (t == nt - 2);
            const char* a1 = cA + (size_t)(t + 1) * kstep;
            const char* a2 = last ? nA : cA + (size_t)(t + 2) * kstep; const char* b2 = last ? nB : cB + (size_t)(t + 2) * kstep;
            const char* a3 = a2 + kstep; const char* b3 = b2 + kstep;
            if (last && has_next) S.a_ready(nxt);
            if constexpr (SP2) {
            PG8_LDB(B0, 0, 0); PG8_LDB(B1, 0, 1); PG8_SCHED; PG8_LDA(At, 0, 0); PG8_STAGEA(PG8_SA(1, 1), a1 + hstep, voffA);
            PG8_WAIT_V(8); PG8_WAIT_L(0); PG8_BAR; PG8_MMA(0, 0, At, B0); PG8_MMA(0, 1, At, B1); PG8_BAR; PG8_SCHED;
            PG8_LDA(At, 0, 1); PG8_STAGE(PG8_SB(0, 0), b2, voffB); PG8_STAGE(PG8_SB(0, 1), b2 + hstep, voffB); PG8_STAGEA(PG8_SA(0, 0), a2, voffA);
            PG8_WAIT_V(8); PG8_WAIT_L(0); PG8_BAR; PG8_MMA(1, 0, At, B0); PG8_MMA(1, 1, At, B1); PG8_BAR; PG8_SCHED;
            PG8_LDB(B0, 1, 0); PG8_LDB(B1, 1, 1); PG8_SCHED; PG8_LDA(At, 1, 0); PG8_STAGEA(PG8_SA(0, 1), a2 + hstep, voffA);
            PG8_WAIT_V(8); PG8_WAIT_L(0); PG8_BAR; PG8_MMA(0, 0, At, B0); PG8_MMA(0, 1, At, B1); PG8_BAR; PG8_SCHED;
            PG8_LDA(At, 1, 1); PG8_STAGE(PG8_SB(1, 0), b3, voffB); PG8_STAGE(PG8_SB(1, 1), b3 + hstep, voffB); PG8_STAGEA(PG8_SA(1, 0), a3, voffA);
            PG8_WAIT_V(8); PG8_WAIT_L(0); PG8_BAR; PG8_MMA(1, 0, At, B0); PG8_MMA(1, 1, At, B1); PG8_BAR; PG8_SCHED;
            } else {
            PG8_LDB(B0, 0, 0); PG8_SCHED; PG8_LDA(At, 0, 0); PG8_STAGEA(PG8_SA(1, 1), a1 + hstep, voffA);
            PG8_WAIT_L(8); PG8_BAR; PG8_WAIT_L(0); PG8_MMA(0, 0, At, B0); PG8_BAR; PG8_SCHED;
            PG8_LDB(B1, 0, 1); PG8_STAGE(PG8_SB(0, 0), b2, voffB);
            PG8_BAR; PG8_WAIT_L(0); PG8_MMA(0, 1, At, B1); PG8_BAR;
            PG8_LDA(At, 0, 1); PG8_STAGEA(PG8_SA(0, 0), a2, voffA);
            PG8_BAR; PG8_WAIT_L(0); PG8_MMA(1, 0, At, B0); PG8_BAR; PG8_SCHED;
            PG8_STAGE(PG8_SB(0, 1), b2 + hstep, voffB);
            PG8_WAIT_V(6); PG8_BAR; PG8_MMA(1, 1, At, B1); PG8_BAR;
            PG8_LDB(B0, 1, 0); PG8_SCHED; PG8_LDA(At, 1, 0); PG8_STAGEA(PG8_SA(0, 1), a2 + hstep, voffA);
            PG8_WAIT_L(8); PG8_BAR; PG8_WAIT_L(0); PG8_MMA(0, 0, At, B0); PG8_BAR; PG8_SCHED;
            PG8_LDB(B1, 1, 1); PG8_STAGE(PG8_SB(1, 0), b3, voffB);
            PG8_BAR; PG8_WAIT_L(0); PG8_MMA(0, 1, At, B1); PG8_BAR;
            PG8_LDA(At, 1, 1); PG8_STAGEA(PG8_SA(1, 0), a3, voffA);
            PG8_BAR; PG8_WAIT_L(0); PG8_MMA(1, 0, At, B0); PG8_BAR; PG8_SCHED;
            PG8_STAGE(PG8_SB(1, 1), b3 + hstep, voffB);
            PG8_WAIT_V(6); PG8_BAR; PG8_MMA(1, 1, At, B1); PG8_BAR;
            }
        }
        if constexpr (ALIGN_EPI) { if (wr == 0) PG8_BAR; }
        if constexpr (!Epi::AFTER_DRAIN) { E(acc, cur, wr, wc, fr, fq); S.done(cur); }
        if (!has_next) break;
#pragma unroll
        for (int a = 0; a < 2; ++a)
#pragma unroll
            for (int b = 0; b < 2; ++b)
#pragma unroll
                for (int m = 0; m < 4; ++m)
#pragma unroll
                    for (int n = 0; n < 2; ++n) acc[a][b][m][n] = (f32x4){0.f, 0.f, 0.f, 0.f};
        cur = nxt; cA = nA; cB = nB; ++ui;
        if constexpr (ALIGN_EPI) { if (wr == 1) PG8_BAR; }
    }
    PG8_WAIT_V(0);
    if constexpr (!ALIGN_EPI) { if (wr == 0) PG8_BAR; }
    PG8_BAR;
    if constexpr (Epi::AFTER_DRAIN) { E.fused(acc, cur, wr, wc, fr, fq, lds, wid, lane); S.done(cur); }
#undef PG8_SA
#undef PG8_SB
#undef PG8_STAGE
#undef PG8_STAGEA
#undef PG8_LDA
#undef PG8_LDB
#undef PG8_MMA
#undef PG8_WAIT_V
#undef PG8_WAIT_L
#undef PG8_BAR
#undef PG8_SCHED
}
}
namespace att {
using bf16 = unsigned short;
using bf16x8 = __attribute__((ext_vector_type(8))) short;
using s16x4  = __attribute__((ext_vector_type(4))) short;
using f32x16 = __attribute__((ext_vector_type(16))) float;
using u32x4  = __attribute__((ext_vector_type(4))) unsigned;
constexpr int KVBLK = 64;
constexpr size_t SHM_V = KVBLK * 128 * 2, SHM_K = KVBLK * 128 * 2;
constexpr size_t SHM_SCR = 2 * SHM_V + 2 * SHM_K;
constexpr size_t SHM_ATTN = SHM_SCR + 8 * 64 * 4;
constexpr float THR = 8.f;
#define KSWZ(row, colB) ((row) * 256 + ((colB) ^ (((row) & 7) << 4)))
#define SBAR() __builtin_amdgcn_sched_barrier(0)
__device__ __forceinline__ int crow(int r, int hi) { return (r & 3) + 8 * (r >> 2) + 4 * hi; }
__device__ __forceinline__ unsigned cvtpk(float lo, float hi) { unsigned r; asm volatile("v_cvt_pk_bf16_f32 %0, %1, %2" : "=v"(r) : "v"(lo), "v"(hi)); return r; }
__device__ __forceinline__ float max3f(float a, float b, float c) { return __builtin_fmaxf(__builtin_fmaxf(a, b), c); }
__device__ __forceinline__ float bf2f(unsigned short b) { return __uint_as_float(((unsigned)b) << 16); }

constexpr float THRL = 8.f;
template <bool MASK, bool FIRST>
__device__ __forceinline__ void partialSM(f32x16& p0, f32x16& p1, float& mhat, f32x16& negm, float& alpha, int mb, int hi) {
  if (MASK) {
#pragma unroll
    for (int r = 0; r < 16; ++r) { const int d = mb + crow(r, hi) + 128;
      if ((unsigned)d > 256u) p0[r] = -INFINITY; if ((unsigned)(d + 32) > 256u) p1[r] = -INFINITY; }
  }
  float pmax;
  { float a = max3f(p0[0], p0[1], p1[0]), b = max3f(p0[2], p0[3], p1[1]); a = max3f(a, p1[2], p1[3]);
#pragma unroll
    for (int r = 4; r < 16; r += 4) { a = max3f(a, p0[r], p0[r + 1]); b = max3f(b, p0[r + 2], p0[r + 3]); a = max3f(a, p1[r], p1[r + 1]); b = max3f(b, p1[r + 2], p1[r + 3]); }
    pmax = fmaxf(a, b); }
  { float pmax2 = pmax; asm volatile("" : "+v"(pmax2));
    auto rr = __builtin_amdgcn_permlane32_swap(__float_as_uint(pmax), __float_as_uint(pmax2), false, false);
    pmax = fmaxf(__uint_as_float(rr[0]), __uint_as_float(rr[1])); }
  alpha = 1.f;
  if (FIRST || !__builtin_expect(__all(pmax <= THRL), 1)) {
    const float dl = FIRST ? pmax : fmaxf(pmax, 0.f);
    mhat += dl;
#pragma unroll
    for (int r = 0; r < 16; ++r) { p0[r] -= dl; p1[r] -= dl; }
#pragma unroll
    for (int r = 0; r < 16; ++r) negm[r] = -mhat;
    asm volatile("" : "+v"(negm));
    alpha = __builtin_amdgcn_exp2f(-dl);
  }
#pragma unroll
  for (int r = 0; r < 16; ++r) p0[r] = __builtin_amdgcn_exp2f(p0[r]);
}
__device__ __forceinline__ void finishSM(f32x16& p0, f32x16& p1, float alpha, float& l_reg, bf16x8& pa0, bf16x8& pa1, bf16x8& pa2, bf16x8& pa3) {
#pragma unroll
  for (int r = 0; r < 16; ++r) p1[r] = __builtin_amdgcn_exp2f(p1[r]);
  float ps = 0;
#pragma unroll
  for (int r = 0; r < 16; ++r) ps += p0[r];
#pragma unroll
  for (int r = 0; r < 16; ++r) ps += p1[r];
  { float ps2 = ps; asm volatile("" : "+v"(ps2));
    auto rr = __builtin_amdgcn_permlane32_swap(__float_as_uint(ps), __float_as_uint(ps2), false, false);
    ps = __uint_as_float(rr[0]) + __uint_as_float(rr[1]); }
  l_reg = l_reg * alpha + ps;
#define PK4(P, BASE, OUT) do { u32x4 w = {cvtpk(P[BASE + 0], P[BASE + 1]), cvtpk(P[BASE + 2], P[BASE + 3]), cvtpk(P[BASE + 4], P[BASE + 5]), cvtpk(P[BASE + 6], P[BASE + 7])}; \
    OUT = *reinterpret_cast<bf16x8*>(&w); } while (0)
  PK4(p0, 0, pa0); PK4(p0, 8, pa1); PK4(p1, 0, pa2); PK4(p1, 8, pa3);
#undef PK4
}
template <int ND0>
__device__ __forceinline__ void qkt(f32x16& p0, f32x16& p1, const char* Ks, const bf16x8* qr, const f32x16& negm, int r32, int hi, int kb0) {
#pragma unroll
  for (int d0 = 0; d0 < ND0; ++d0) { const int cb = ((kb0 + d0) * 16 + hi * 8) * 2;
    bf16x8 b0 = *reinterpret_cast<const bf16x8*>(Ks + KSWZ(r32, cb));
    bf16x8 b1 = *reinterpret_cast<const bf16x8*>(Ks + KSWZ(32 + r32, cb));
    if (d0 == 0) { p0 = __builtin_amdgcn_mfma_f32_32x32x16_bf16(b0, qr[0], negm, 0, 0, 0); p1 = __builtin_amdgcn_mfma_f32_32x32x16_bf16(b1, qr[0], negm, 0, 0, 0); }
    else { p0 = __builtin_amdgcn_mfma_f32_32x32x16_bf16(b0, qr[d0], p0, 0, 0, 0); p1 = __builtin_amdgcn_mfma_f32_32x32x16_bf16(b1, qr[d0], p1, 0, 0, 0); } }
}
__device__ __forceinline__ int v_st(int k, int c) { const int kk = k; return ((kk >> 3) * 4 + (c >> 5)) * 512 + ((kk & 7) * 32 + (c & 31)) * 2; }
__device__ __forceinline__ int v_rd_base(int lane) { return ((lane & 3) << 3) | (((lane >> 2) & 3) << 6) | (((lane >> 4) & 1) << 5) | (((lane >> 5) & 1) << 8); }
constexpr int v_rd_off(int d0, int ks, int half) { return d0 * 512 + ks * 4096 + half * 2048; }
template <int OFF> __device__ __forceinline__ s16x4 tr_read(int vb) {
  s16x4 r; asm volatile("ds_read_b64_tr_b16 %0, %1 offset:%2" : "=&v"(r) : "v"(vb), "i"(OFF) : "memory"); return r;
}
template <int D0> __device__ __forceinline__ void pv_one(f32x16& od, int vb, bf16x8 pa0, bf16x8 pa1, bf16x8 pa2, bf16x8 pa3) {
  const s16x4 l0 = tr_read<v_rd_off(D0, 0, 0)>(vb), h0 = tr_read<v_rd_off(D0, 0, 1)>(vb), l1 = tr_read<v_rd_off(D0, 1, 0)>(vb), h1 = tr_read<v_rd_off(D0, 1, 1)>(vb);
  const s16x4 l2 = tr_read<v_rd_off(D0, 2, 0)>(vb), h2 = tr_read<v_rd_off(D0, 2, 1)>(vb), l3 = tr_read<v_rd_off(D0, 3, 0)>(vb), h3 = tr_read<v_rd_off(D0, 3, 1)>(vb);
  asm volatile("s_waitcnt lgkmcnt(0)" ::: "memory"); SBAR();
#define PK(L, H) (bf16x8){L[0], L[1], L[2], L[3], H[0], H[1], H[2], H[3]}
  od = __builtin_amdgcn_mfma_f32_32x32x16_bf16(pa0, PK(l0, h0), od, 0, 0, 0);
  od = __builtin_amdgcn_mfma_f32_32x32x16_bf16(pa1, PK(l1, h1), od, 0, 0, 0);
  od = __builtin_amdgcn_mfma_f32_32x32x16_bf16(pa2, PK(l2, h2), od, 0, 0, 0);
  od = __builtin_amdgcn_mfma_f32_32x32x16_bf16(pa3, PK(l3, h3), od, 0, 0, 0);
#undef PK
}
__device__ __forceinline__ void pv_d0(f32x16* o, int vb, bf16x8 pa0, bf16x8 pa1, bf16x8 pa2, bf16x8 pa3) {
  pv_one<0>(o[0], vb, pa0, pa1, pa2, pa3); pv_one<1>(o[1], vb, pa0, pa1, pa2, pa3); pv_one<2>(o[2], vb, pa0, pa1, pa2, pa3); pv_one<3>(o[3], vb, pa0, pa1, pa2, pa3);
}

template <int ND0, bool MASK, int SDEPTH, bool FIRSTREF, bool SKIP>
__device__ __forceinline__ void attn_core(const bf16x8* qr, const bf16* __restrict__ Kt, const bf16* __restrict__ Vt, const long ld, const int NT, const int mb0, const int kb0,
                                          float mhat, float& l_reg, f32x16 (&o)[4], char* lds, const int wv) {
  const int tid = opaque_tid(wv), wid = tid >> 6, lane = tid & 63, r32 = lane & 31, hi = lane >> 5;
  char* V_lds = lds; char* K_lds = lds + 2 * SHM_V;
  float* al_l = (float*)(lds + SHM_SCR) + wid * 64 + 32;
  const int sr = tid >> 4, sc = (tid & 15) * 8, vst0 = v_st(sr, sc), vst1 = v_st(32 + sr, sc);
  const int vb0 = (int)(uintptr_t)V_lds + v_rd_base(lane);
  const int wrel = (MASK && SKIP) ? __builtin_amdgcn_readfirstlane(mb0 + r32) : 0;
#define ACT(t) (!(MASK && SKIP) || (unsigned)(wrel + 64 * (t) + 191) <= 350u)
  struct { bf16x8 vs0, vs1, ks0, ks1; } sr_[SDEPTH];
#define SLOAD(i, k0) do { sr_[i].vs0 = *(const bf16x8*)(Vt + (long)(k0) * ld); sr_[i].vs1 = *(const bf16x8*)(Vt + (long)((k0) + 32) * ld); \
    sr_[i].ks0 = *(const bf16x8*)(Kt + (long)(k0) * ld); sr_[i].ks1 = *(const bf16x8*)(Kt + (long)((k0) + 32) * ld); } while (0)
#define SWRITE(b, i) do { *(bf16x8*)(V_lds + (b) * SHM_V + vst0) = sr_[i].vs0; *(bf16x8*)(V_lds + (b) * SHM_V + vst1) = sr_[i].vs1; const int kc = sc * 2; \
    *(bf16x8*)(K_lds + (b) * SHM_K + KSWZ(sr, kc)) = sr_[i].ks0; *(bf16x8*)(K_lds + (b) * SHM_K + KSWZ(32 + sr, kc)) = sr_[i].ks1; } while (0)
#define SWAIT() do { if constexpr (SDEPTH == 2) asm volatile("s_waitcnt vmcnt(4)" ::: "memory"); else asm volatile("s_waitcnt vmcnt(0)" ::: "memory"); } while (0)
#define RESC(a) do { if (__any((a) < 1.f)) { if (hi == 0) al_l[r32] = (a); asm volatile("s_waitcnt lgkmcnt(0)" ::: "memory"); \
    _Pragma("unroll") for (int d = 0; d < 4; ++d) _Pragma("unroll") for (int r = 0; r < 16; ++r) o[d][r] *= al_l[crow(r, hi)]; } } while (0)
  f32x16 pA0, pA1, pB0, pB1; float alA = 1.f, alB = 1.f; bf16x8 pa0, pa1, pa2, pa3;
  f32x16 negm;
#pragma unroll
  for (int r = 0; r < 16; ++r) negm[r] = -mhat;
  asm volatile("" : "+v"(negm));
  constexpr int SE = 0, SO = SDEPTH - 1;
  bool aA = ACT(0), aB = false;
  SLOAD(SE, 0); asm volatile("s_waitcnt vmcnt(0)" ::: "memory"); SWRITE(0, SE); __syncthreads();
  if (aA) { qkt<ND0>(pA0, pA1, K_lds, qr, negm, r32, hi, kb0); partialSM<MASK, FIRSTREF>(pA0, pA1, mhat, negm, alA, mb0, hi); }
  SLOAD(SO, KVBLK); if constexpr (SDEPTH == 2) { if (2 < NT) SLOAD(SE, 2 * KVBLK); }
  SWAIT(); SWRITE(1, SO); __syncthreads();
  for (int j = 1; j + 1 < NT; j += 2) {
    aB = ACT(j);
    SBAR(); if (aB) qkt<ND0>(pB0, pB1, K_lds + SHM_K, qr, negm, r32, hi, kb0);
    if (aA) finishSM(pA0, pA1, alA, l_reg, pa0, pa1, pa2, pa3); SBAR();
    SLOAD(SO, (j + SDEPTH) * KVBLK); SBAR();
    if (aA) pv_d0(o, vb0, pa0, pa1, pa2, pa3);
    alB = 1.f; if (aB) partialSM<MASK, false>(pB0, pB1, mhat, negm, alB, mb0 + j * KVBLK, hi);
    __syncthreads(); SWAIT(); SWRITE(0, SE);
    RESC(alB); __syncthreads();
    aA = ACT(j + 1);
    SBAR(); if (aA) qkt<ND0>(pA0, pA1, K_lds, qr, negm, r32, hi, kb0);
    if (aB) finishSM(pB0, pB1, alB, l_reg, pa0, pa1, pa2, pa3); SBAR();
    if (SDEPTH == 1 || j + 3 < NT) SLOAD(SE, (j + 1 + SDEPTH) * KVBLK); SBAR();
    if (aB) pv_d0(o, vb0 + (int)SHM_V, pa0, pa1, pa2, pa3);
    alA = 1.f; if (aA) partialSM<MASK, false>(pA0, pA1, mhat, negm, alA, mb0 + (j + 1) * KVBLK, hi);
    __syncthreads(); SWAIT(); SWRITE(1, SO);
    RESC(alA); __syncthreads();
  }
  aB = ACT(NT - 1);
  SBAR(); if (aB) qkt<ND0>(pB0, pB1, K_lds + SHM_K, qr, negm, r32, hi, kb0);
  if (aA) finishSM(pA0, pA1, alA, l_reg, pa0, pa1, pa2, pa3); SBAR();
  if (aA) pv_d0(o, vb0, pa0, pa1, pa2, pa3);
  alB = 1.f; if (aB) partialSM<MASK, false>(pB0, pB1, mhat, negm, alB, mb0 + (NT - 1) * KVBLK, hi);
  __syncthreads(); RESC(alB);
  if (aB) { finishSM(pB0, pB1, alB, l_reg, pa0, pa1, pa2, pa3); SBAR();
    pv_d0(o, vb0 + (int)SHM_V, pa0, pa1, pa2, pa3); }
#undef ACT
#undef SLOAD
#undef SWRITE
#undef SWAIT
#undef RESC
}

__device__ __forceinline__ float rowmax_merged(const f32x16& p0, const f32x16& p1) {
  float a = max3f(p0[0], p0[1], p1[0]), b = max3f(p0[2], p0[3], p1[1]); a = max3f(a, p1[2], p1[3]);
#pragma unroll
  for (int r = 4; r < 16; r += 4) { a = max3f(a, p0[r], p0[r + 1]); b = max3f(b, p0[r + 2], p0[r + 3]); a = max3f(a, p1[r], p1[r + 1]); b = max3f(b, p1[r + 2], p1[r + 3]); }
  float pmax = fmaxf(a, b), pmax2 = pmax; asm volatile("" : "+v"(pmax2));
  auto rr = __builtin_amdgcn_permlane32_swap(__float_as_uint(pmax), __float_as_uint(pmax2), false, false);
  return fmaxf(__uint_as_float(rr[0]), __uint_as_float(rr[1]));
}
__device__ __forceinline__ float exp_sum(f32x16& p0, f32x16& p1, bool with_p0) {
  if (with_p0) {
#pragma unroll
    for (int r = 0; r < 16; ++r) p0[r] = __builtin_amdgcn_exp2f(p0[r]);
  }
#pragma unroll
  for (int r = 0; r < 16; ++r) p1[r] = __builtin_amdgcn_exp2f(p1[r]);
  float ps = 0.f;
#pragma unroll
  for (int r = 0; r < 16; ++r) ps += p0[r];
#pragma unroll
  for (int r = 0; r < 16; ++r) ps += p1[r];
  return ps;
}
template <int ND0>
__device__ __forceinline__ void tailSM(f32x16& p0, f32x16& p1, float& mhat, f32x16& negm, float& alpha, float& ps, const char* Ks, const bf16x8* qr, int r32, int hi, int kb0) {
  alpha = 1.f;
  float s = exp_sum(p0, p1, true);
  if (!__builtin_expect(__all(s <= 256.f), 1)) {
    qkt<ND0>(p0, p1, Ks, qr, negm, r32, hi, kb0);
    const float dl = fmaxf(rowmax_merged(p0, p1), 0.f);
    mhat += dl;
#pragma unroll
    for (int r = 0; r < 16; ++r) { p0[r] -= dl; p1[r] -= dl; }
#pragma unroll
    for (int r = 0; r < 16; ++r) negm[r] = -mhat;
    asm volatile("" : "+v"(negm));
    alpha = __builtin_amdgcn_exp2f(-dl);
    s = exp_sum(p0, p1, true);
  }
  ps = s;
}
__device__ __forceinline__ void finishP(const f32x16& p0, const f32x16& p1, float alpha, float ps, float& l_reg, bf16x8& pa0, bf16x8& pa1, bf16x8& pa2, bf16x8& pa3) {
  { float ps2 = ps; asm volatile("" : "+v"(ps2));
    auto rr = __builtin_amdgcn_permlane32_swap(__float_as_uint(ps), __float_as_uint(ps2), false, false);
    ps = __uint_as_float(rr[0]) + __uint_as_float(rr[1]); }
  l_reg = l_reg * alpha + ps;
#define FP_PK4(P, BASE, OUT) do { u32x4 w = {cvtpk(P[BASE + 0], P[BASE + 1]), cvtpk(P[BASE + 2], P[BASE + 3]), cvtpk(P[BASE + 4], P[BASE + 5]), cvtpk(P[BASE + 6], P[BASE + 7])}; \
    OUT = *reinterpret_cast<bf16x8*>(&w); } while (0)
  FP_PK4(p0, 0, pa0); FP_PK4(p0, 8, pa1); FP_PK4(p1, 0, pa2); FP_PK4(p1, 8, pa3);
#undef FP_PK4
}

constexpr size_t RING_SCR = 6 * 16384;
template <int ND0, bool MASK, bool FIRSTREF>
__device__ __forceinline__ void attn_core_ring(const bf16x8* qr, const char* __restrict__ zb, const unsigned offK, const unsigned offV, const long ld, const int NT, const int mb0, const int kb0,
                                               float mhat, float& l_reg, f32x16 (&o)[4], char* lds, const int wv) {
  const int tid = opaque_tid(wv), wid = tid >> 6, lane = tid & 63, r32 = lane & 31, hi = lane >> 5;
  char* V_lds = lds; char* K_lds = lds + 3 * 16384;
  float* al_l = (float*)(lds + RING_SCR) + wid * 64 + 32;
  const int sr = tid >> 4, sc = (tid & 15) * 8, vst0 = v_st(sr, sc), kst0 = KSWZ(sr, sc * 2);
  const int vb0 = (int)(uintptr_t)V_lds + v_rd_base(lane);
  bf16x8 svs0, svs1, sks0, sks1;
#define SLOAD(k0) do { const char* b0_ = zb + (long)(k0) * (ld * 2); const char* b1_ = b0_ + 32 * (ld * 2);                   \
    unsigned ov_ = offV, ok_ = offK; asm volatile("" : "+v"(ov_), "+v"(ok_));     \
    svs0 = *(const bf16x8*)(b0_ + ov_); svs1 = *(const bf16x8*)(b1_ + ov_); sks0 = *(const bf16x8*)(b0_ + ok_); sks1 = *(const bf16x8*)(b1_ + ok_); } while (0)
#define SWRITE(off) do { char* vw_ = V_lds + (off) + vst0; *(bf16x8*)vw_ = svs0; *(bf16x8*)(vw_ + 8192) = svs1;              \
    char* kw_ = K_lds + (off) + kst0; *(bf16x8*)kw_ = sks0; *(bf16x8*)(kw_ + 8192) = sks1; } while (0)
#define RESC(a) do { if (__any((a) < 1.f)) { if (hi == 0) al_l[r32] = (a); asm volatile("s_waitcnt lgkmcnt(0)" ::: "memory"); \
    _Pragma("unroll") for (int d = 0; d < 4; ++d) _Pragma("unroll") for (int r = 0; r < 16; ++r) o[d][r] *= al_l[crow(r, hi)]; } } while (0)
#define LBAR() asm volatile("s_waitcnt lgkmcnt(0)\n\ts_barrier" ::: "memory")
#define ROT() do { const int t_ = prv; prv = cur; cur = nxt; nxt = t_; } while (0)
  static_assert(!MASK, "the ring body has no mask path");
  f32x16 pA0, pA1, pB0, pB1; float alA, alB, psA, psB; bf16x8 pa0, pa1, pa2, pa3;
  f32x16 negm;
#pragma unroll
  for (int r = 0; r < 16; ++r) negm[r] = -mhat;
  asm volatile("" : "+v"(negm));
  int prv = 2 * 16384, cur = 0, nxt = 16384;
  SLOAD(0); asm volatile("s_waitcnt vmcnt(0)" ::: "memory"); SWRITE(0); SLOAD(KVBLK);
  __syncthreads();
  qkt<ND0>(pA0, pA1, K_lds + cur, qr, negm, r32, hi, kb0);
  SWRITE(nxt); if (2 < NT) SLOAD(2 * KVBLK);
  partialSM<MASK, FIRSTREF>(pA0, pA1, mhat, negm, alA, mb0, hi);
  psA = exp_sum(pA0, pA1, false);
  ROT();
  for (int j = 1; j + 1 < NT; j += 2) {
    LBAR();
    SBAR(); qkt<ND0>(pB0, pB1, K_lds + cur, qr, negm, r32, hi, kb0);
    SWRITE(nxt); if (j + 2 < NT) SLOAD((j + 2) * KVBLK); SBAR();
    finishP(pA0, pA1, alA, psA, l_reg, pa0, pa1, pa2, pa3); SBAR();
    pv_d0(o, vb0 + prv, pa0, pa1, pa2, pa3); tailSM<ND0>(pB0, pB1, mhat, negm, alB, psB, K_lds + cur, qr, r32, hi, kb0);
    RESC(alB); ROT();
    LBAR();
    SBAR(); qkt<ND0>(pA0, pA1, K_lds + cur, qr, negm, r32, hi, kb0);
    SWRITE(nxt); if (j + 3 < NT) SLOAD((j + 3) * KVBLK); SBAR();
    finishP(pB0, pB1, alB, psB, l_reg, pa0, pa1, pa2, pa3); SBAR();
    pv_d0(o, vb0 + prv, pa0, pa1, pa2, pa3); tailSM<ND0>(pA0, pA1, mhat, negm, alA, psA, K_lds + cur, qr, r32, hi, kb0);
    RESC(alA); ROT();
  }
  LBAR();
  SBAR(); qkt<ND0>(pB0, pB1, K_lds + cur, qr, negm, r32, hi, kb0);
  finishP(pA0, pA1, alA, psA, l_reg, pa0, pa1, pa2, pa3); SBAR();
  pv_d0(o, vb0 + prv, pa0, pa1, pa2, pa3); tailSM<ND0>(pB0, pB1, mhat, negm, alB, psB, K_lds + cur, qr, r32, hi, kb0);
  RESC(alB);
  finishP(pB0, pB1, alB, psB, l_reg, pa0, pa1, pa2, pa3); SBAR();
  pv_d0(o, vb0 + cur, pa0, pa1, pa2, pa3);
  __syncthreads();
#undef SLOAD
#undef SWRITE
#undef RESC
#undef ROT
#undef LBAR
}
}
constexpr int DM = 2048, NTOK = 32768  , DEPTH = 4, AB_IN = 5120, C_INW = 3072, DFF = 8192;
constexpr float EPS = 1e-6f;
constexpr size_t MiB = 1u << 20;
constexpr size_t WS_CTL = 0, CTL_ZERO_BYTES = 1 * MiB;
constexpr size_t WS_TABB = 1 * MiB, WS_TABC = 2 * MiB, WS_MISC = 4 * MiB, WS_R2 = 5 * MiB;
constexpr size_t WS_WINAB = 8 * MiB, WS_WOUTAB = 48 * MiB, WS_WINC = 64 * MiB, WS_WOUTC = 88 * MiB, WS_WUP = 104 * MiB, WS_WDOWN = 232 * MiB;
constexpr size_t WS_H = 360 * MiB, WS_Z = 488 * MiB, WS_CAT = 808 * MiB, WS_HID = 488 * MiB, WS_OUT = 1000 * MiB, WS_END = 1128 * MiB;
static_assert(WS_WINAB + 2ull * AB_IN * DM * 2 <= WS_WOUTAB && WS_WOUTAB + 2ull * DM * DM * 2 <= WS_WINC && WS_WINC + 2ull * C_INW * DM * 2 <= WS_WOUTC && WS_WOUTC + 2ull * DM * DM * 2 <= WS_WUP &&
              WS_WUP + 4ull * DFF * DM * 2 <= WS_WDOWN && WS_WDOWN + 4ull * DFF * DM * 2 <= WS_H && WS_H + (size_t)NTOK * DM * 2 <= WS_Z && WS_Z + (size_t)NTOK * AB_IN * 2 <= WS_CAT &&
              WS_CAT + (size_t)NTOK * DM * 2 <= WS_OUT && WS_HID + (size_t)NTOK * DFF * 2 <= WS_OUT && WS_OUT + (size_t)NTOK * DM * 2 <= WS_END, "d_ws map");
constexpr int CW_BAR = 4096;
constexpr int NWAVES = 8;
constexpr int LDS_BYTES = 147456, RING_BYTES = 131072, MISC_OFF = RING_BYTES + 320;

#define GAS __attribute__((address_space(1)))
#define LAS __attribute__((address_space(3)))
typedef unsigned short bf16;
typedef unsigned v4u __attribute__((ext_vector_type(4)));
typedef unsigned v2u __attribute__((ext_vector_type(2)));
typedef float f32x4 __attribute__((ext_vector_type(4)));
typedef short bf16x8 __attribute__((ext_vector_type(8)));
typedef GAS unsigned gu32;
#define RLX_AGENT __ATOMIC_RELAXED, __HIP_MEMORY_SCOPE_AGENT
#define LDS_WAIT() asm volatile("s_waitcnt lgkmcnt(0)" ::: "memory")
__device__ __forceinline__ unsigned f2bf(float f) { unsigned u = __builtin_bit_cast(unsigned, f); return (u + 0x7fffu + ((u >> 16) & 1u)) >> 16; }
__device__ __forceinline__ unsigned pk2(float lo, float hi) { return f2bf(lo) | (f2bf(hi) << 16); }
__device__ __forceinline__ float bflo(unsigned w) { return __uint_as_float(w << 16); }
__device__ __forceinline__ float bfhi(unsigned w) { return __uint_as_float(w & 0xffff0000u); }

#define XB_TMO      128
#define XB_XCNT(j)  (256  + 64 * (j))
#define XB_XSUB(j)  (1280 + 64 * (j))
#define XB_XGEN(j)  (2304 + 64 * (j))
#define XB_TOP      3328
#define XB_TOPGEN   3392
#define XCD_BAR_WORDS 3456
#define XB_SPIN_CAP (1u << 18)

__device__ __forceinline__ unsigned xb_ld(unsigned* p)              { return __hip_atomic_load(p, __ATOMIC_RELAXED, __HIP_MEMORY_SCOPE_AGENT); }
__device__ __forceinline__ unsigned xb_add(unsigned* p, unsigned v) { return __hip_atomic_fetch_add(p, v, __ATOMIC_RELAXED, __HIP_MEMORY_SCOPE_AGENT); }
__device__ __forceinline__ unsigned xb_xcc_id() { return (unsigned)__builtin_amdgcn_s_getreg((3 << 11) | 20) & 0xFu; }
#define XB_SPIN(cond, bar) do { unsigned _sp = 0; while (cond) { __builtin_amdgcn_s_sleep(1); \
    if ((++_sp & 255u) == 0u) { if (xb_ld(&(bar)[XB_TMO])) break; if (_sp > XB_SPIN_CAP) { atomicAdd(&(bar)[XB_TMO], 1u); break; } } } } while (0)

struct XcdBarrier {
    unsigned* bar; unsigned x; unsigned wv;
    volatile LAS unsigned* st;
};

__device__ __forceinline__ XcdBarrier xcd_barrier_post(unsigned* bar, volatile LAS unsigned* st) {
    XcdBarrier b; b.bar = bar; b.x = xb_xcc_id(); b.st = st; b.wv = (unsigned)__builtin_amdgcn_readfirstlane(threadIdx.x >> 6);
    if (threadIdx.x == 0) (void)xb_add(&bar[XB_XCNT(b.x)], 1u);
    return b;
}
__device__ __forceinline__ void xcd_barrier_complete(unsigned* bar, unsigned x, unsigned& nloc, unsigned& nx) {
    const unsigned G = gridDim.x * gridDim.y * gridDim.z;
    unsigned sum, cnt, mine, sp = 0u;
    for (;;) {
        sum = 0u; cnt = 0u; mine = 0u;
#pragma unroll
        for (unsigned j = 0; j < 16; ++j) { const unsigned c = xb_ld(&bar[XB_XCNT(j)]); sum += c; cnt += (c > 0u) ? 1u : 0u; mine = (j == x) ? c : mine; }
        if (sum == G) break;
        __builtin_amdgcn_s_sleep(1);
        if ((++sp & 255u) == 0u) { if (xb_ld(&bar[XB_TMO])) break; if (sp > XB_SPIN_CAP) { atomicAdd(&bar[XB_TMO], 1u); break; } }
    }
    nloc = mine > 0u ? mine : 1u; nx = cnt > 0u ? cnt : 1u;
}

__device__ __forceinline__ void xcd_barrier(const XcdBarrier& b) {
    asm volatile("s_waitcnt vmcnt(0)" ::: "memory");
    __syncthreads();
    if (b.wv == 0u && __builtin_amdgcn_mbcnt_hi(~0u, __builtin_amdgcn_mbcnt_lo(~0u, 0u)) == 0u) {
        unsigned* bar = b.bar; unsigned bx = b.x; asm volatile("" : "+s"(bx));
        __builtin_amdgcn_s_waitcnt(0);
        unsigned nloc = b.st[0], nx = b.st[1];
        if (nloc == 0u) { xcd_barrier_complete(bar, bx, nloc, nx); b.st[0] = nloc; b.st[1] = nx; }
        const unsigned old = xb_add(&bar[XB_XSUB(bx)], 1u);
        const unsigned gen = old / nloc;
        if (old + 1u == (gen + 1u) * nloc) {
            __builtin_amdgcn_fence(__ATOMIC_RELEASE, "agent");
            asm volatile("s_waitcnt vmcnt(0)" ::: "memory");
            const unsigned og = xb_add(&bar[XB_TOP], 1u);
            const unsigned tg = og / nx;
            if (og + 1u == (tg + 1u) * nx) xb_add(&bar[XB_TOPGEN], 1u);
            else XB_SPIN(xb_ld(&bar[XB_TOPGEN]) == tg, bar);
            __builtin_amdgcn_fence(__ATOMIC_ACQUIRE, "agent");
            xb_add(&bar[XB_XGEN(bx)], 1u);
            asm volatile("s_waitcnt vmcnt(0)" ::: "memory");
        } else {
            XB_SPIN(xb_ld(&bar[XB_XGEN(bx)]) == gen, bar);
            __builtin_amdgcn_fence(__ATOMIC_ACQUIRE, "agent");
            asm volatile("s_waitcnt vmcnt(0)" ::: "memory");
        }
    }
    __syncthreads();
}
__device__ const double ROPE_INV[16] = { 1.0, 0.44036660267178046, 0.19392274474868576, 0.08539710028576561, 0.03760603093086393, 0.016560440080994446, 0.007292664737217109,
    0.003211445994752591, 0.001414213562373095, 0.000622772421914596, 0.0002742481756762073, 0.00012076973741146504, 5.318295896944988e-05, 2.341999896140934e-05,
    1.031338537721246e-05, 4.5416704806078695e-06 };
__device__ __forceinline__ void sincos_d(double a, float& s, float& c) {
    const double k = rint(a * 0.63661977236758134308);
    double y = fma(-k, 1.57079632679489655800e+00, a); y = fma(-k, 6.12323399573676603587e-17, y);
    const double y2 = y * y;
    double sp = -7.647163731819816e-13; sp = fma(sp, y2, 1.6059043836821613e-10); sp = fma(sp, y2, -2.505210838544172e-08); sp = fma(sp, y2, 2.7557319223985893e-06);
    sp = fma(sp, y2, -1.984126984126984e-04); sp = fma(sp, y2, 8.333333333333333e-03); sp = fma(sp, y2, -1.6666666666666666e-01); sp = fma(sp * y2, y, y);
    double cp = 4.779477332387385e-14; cp = fma(cp, y2, -1.1470745597729725e-11); cp = fma(cp, y2, 2.08767569878681e-09); cp = fma(cp, y2, -2.755731922398589e-07);
    cp = fma(cp, y2, 2.48015873015873e-05); cp = fma(cp, y2, -1.388888888888889e-03); cp = fma(cp, y2, 4.1666666666666664e-02); cp = fma(cp, y2, -0.5); cp = fma(cp, y2, 1.0);
    const int q = ((int)((long long)k)) & 3;
    const double ss = (q & 1) ? cp : sp, cc = (q & 1) ? sp : cp;
    s = (float)((q & 2) ? -ss : ss); c = (float)(((q + 1) & 2) ? -cc : cc);
}
__device__ __forceinline__ float wave_sum(float v) {
    v = xor_add<1>(v); v = xor_add<2>(v); v = xor_add<4>(v); v = xor_add<8>(v); v = xor_add<16>(v); v = xor_add<32>(v);
    return v;
}
__device__ __forceinline__ void p0_transpose_item(const float* W, int K, int N, bf16* WT, LAS float* scr, int item, int lane, const float* gk) {
    const int nblk = N / 32, kb = item / nblk, nb = item % nblk, k0 = 64 * kb, n0 = 32 * nb;
#pragma unroll 8
    for (int i = 0; i < 32; ++i) { const int kk = 2 * i + (lane >> 5); scr[kk * 33 + (lane & 31)] = W[(size_t)(k0 + kk) * N + n0 + (lane & 31)] * (gk ? gk[k0 + kk] : 1.f); }
    LDS_WAIT(); asm volatile("" ::: "memory");
    const int c = lane & 7;
#pragma unroll
    for (int j = 0; j < 4; ++j) { const int n = (lane >> 3) + 8 * j; const LAS float* s = scr + (8 * c) * 33 + n;
        v4u o; o.x = pk2(s[0 * 33], s[1 * 33]); o.y = pk2(s[2 * 33], s[3 * 33]); o.z = pk2(s[4 * 33], s[5 * 33]); o.w = pk2(s[6 * 33], s[7 * 33]);
        *(GAS v4u*)(WT + (size_t)(n0 + n) * K + k0 + 8 * c) = o; }
    LDS_WAIT(); asm volatile("" ::: "memory");
}

struct Args { const float* in[18]; float* out; unsigned char* ws; int ph_lo, ph_hi; };

__device__ __forceinline__ void prologue(const Args& a, LAS unsigned char* lds, int gw, int NGW, int lane, int wave) {
    unsigned char* ws = a.ws;
    LAS float* scr = (LAS float*)(lds + wave * 16384);
    constexpr int I0 = 32 * 160, I1 = 32 * 64, I2 = 32 * 96, I3 = 32 * 64, I4 = 32 * 256, I5 = 128 * 64;
    constexpr int NITEMS = 2 * I0 + 2 * I1 + 2 * I2 + 2 * I3 + 4 * I4 + 4 * I5;
    for (int it = gw; it < NITEMS; it += NGW) {
        int r = it;
        if (r < 2 * I0) { const int j = r / I0; p0_transpose_item(a.in[6] + (size_t)j * DM * AB_IN, DM, AB_IN, (bf16*)(ws + WS_WINAB) + (size_t)j * AB_IN * DM, scr, r % I0, lane, a.in[2] + (2 * j) * DM); continue; } r -= 2 * I0;
        if (r < 2 * I1) { const int j = r / I1; p0_transpose_item(a.in[7] + (size_t)j * DM * DM, DM, DM, (bf16*)(ws + WS_WOUTAB) + (size_t)j * DM * DM, scr, r % I1, lane, nullptr); continue; } r -= 2 * I1;
        if (r < 2 * I2) { const int j = r / I2; p0_transpose_item(a.in[13] + (size_t)j * DM * C_INW, DM, C_INW, (bf16*)(ws + WS_WINC) + (size_t)j * C_INW * DM, scr, r % I2, lane, a.in[2] + (2 * j + 1) * DM); continue; } r -= 2 * I2;
        if (r < 2 * I3) { const int j = r / I3; p0_transpose_item(a.in[14] + (size_t)j * DM * DM, DM, DM, (bf16*)(ws + WS_WOUTC) + (size_t)j * DM * DM, scr, r % I3, lane, nullptr); continue; } r -= 2 * I3;
        if (r < 4 * I4) { const int j = r / I4; p0_transpose_item(a.in[16] + (size_t)j * DM * DFF, DM, DFF, (bf16*)(ws + WS_WUP) + (size_t)j * DFF * DM, scr, r % I4, lane, a.in[4] + j * DM); continue; } r -= 4 * I4;
        { const int j = r / I5; p0_transpose_item(a.in[17] + (size_t)j * DFF * DM, DFF, DM, (bf16*)(ws + WS_WDOWN) + (size_t)j * DM * DFF, scr, r % I5, lane, nullptr); }
    }
    float* tabB = (float*)(ws + WS_TABB); float* tabC = (float*)(ws + WS_TABC);
    for (int e = gw * 64 + lane; e < 16384 * 24; e += NGW * 64) {
        if (e < 16384 * 8) { const int pos = e >> 3, j = e & 7; float s, c; sincos_d((double)pos * ROPE_INV[2 * j], s, c); tabB[pos * 16 + j] = c; tabB[pos * 16 + 8 + j] = s; }
        else { const int e2 = e - 16384 * 8, pos = e2 >> 4, j = e2 & 15; float s, c; sincos_d((double)pos * ROPE_INV[j], s, c); tabC[pos * 32 + j] = c; tabC[pos * 32 + 16 + j] = s; }
    }
    if (gw == 0 && lane < 2) {
        const float* lv = a.in[11] + lane * 256; float d0 = 0.f, d1 = 0.f;
        for (int i = 0; i < 64; ++i) { d0 += lv[i] * lv[64 + i]; d1 += lv[128 + i] * lv[192 + i]; }
        const float li = lane == 0 ? 0.2f : 0.4707130183435842f;
        float* misc = (float*)(ws + WS_MISC);
        misc[lane] = __builtin_amdgcn_exp2f(d0 * 1.4426950408889634f) - __builtin_amdgcn_exp2f(d1 * 1.4426950408889634f) + li;
        misc[2 + lane] = 1.0f - li;
    }
}

template <int MODE, int RB>
__device__ __forceinline__ void rowpass(const float* xin, float* xout, bf16* XB, const bf16* OUT, const float* gpost, float* R2, int gw, int NGW, int lane) {
    f32x4 gp[4][2];
    if (MODE != 0) {
#pragma unroll
        for (int k = 0; k < 4; ++k) { gp[k][0] = *(const f32x4*)(gpost + 512 * k + 8 * lane); gp[k][1] = *(const f32x4*)(gpost + 512 * k + 8 * lane + 4); }
    }
    for (int row0 = gw * RB; row0 < NTOK; row0 += NGW * RB) {
        v4u xw[RB][4], ow[RB][4]; f32x4 xf[RB][4][2];
#pragma unroll
        for (int rb = 0; rb < RB; ++rb) {
            const int row = row0 + rb;
            if (MODE == 0) {
                const GAS f32x4* xr = (const GAS f32x4*)(xin + (size_t)row * DM) + 2 * lane;
#pragma unroll
                for (int k = 0; k < 4; ++k) { xf[rb][k][0] = xr[128 * k]; xf[rb][k][1] = xr[128 * k + 1]; }
            } else {
                const GAS v4u* xr = (const GAS v4u*)(XB + (size_t)row * DM) + lane;
                const GAS v4u* orow = (const GAS v4u*)(OUT + (size_t)row * DM) + lane;
#pragma unroll
                for (int k = 0; k < 4; ++k) { xw[rb][k] = __builtin_nontemporal_load(xr + 64 * k); ow[rb][k] = __builtin_nontemporal_load(orow + 64 * k); }
            }
        }
#pragma unroll
        for (int rb = 0; rb < RB; ++rb) {
            const int row = row0 + rb;
            f32x4 x[4][2];
            if (MODE == 0) {
#pragma unroll
                for (int k = 0; k < 4; ++k) { x[k][0] = xf[rb][k][0]; x[k][1] = xf[rb][k][1]; }
            } else {
                f32x4 o[4][2]; float ss = 0.f;
#pragma unroll
                for (int k = 0; k < 4; ++k) { const v4u w = ow[rb][k]; o[k][0] = (f32x4){bflo(w.x), bfhi(w.x), bflo(w.y), bfhi(w.y)}; o[k][1] = (f32x4){bflo(w.z), bfhi(w.z), bflo(w.w), bfhi(w.w)};
#pragma unroll
                    for (int h = 0; h < 2; ++h) ss += (o[k][h].x * o[k][h].x + o[k][h].y * o[k][h].y) + (o[k][h].z * o[k][h].z + o[k][h].w * o[k][h].w); }
                const float r1 = 1.0f / sqrtf(wave_sum(ss) * (1.0f / DM) + EPS);
#pragma unroll
                for (int k = 0; k < 4; ++k) { const v4u w = xw[rb][k];
                    x[k][0] = (f32x4){bflo(w.x), bfhi(w.x), bflo(w.y), bfhi(w.y)} + (o[k][0] * r1) * gp[k][0];
                    x[k][1] = (f32x4){bflo(w.z), bfhi(w.z), bflo(w.w), bfhi(w.w)} + (o[k][1] * r1) * gp[k][1]; }
            }
            if (MODE == 2) {
                GAS f32x4* xo = (GAS f32x4*)(xout + (size_t)row * DM) + 2 * lane;
#pragma unroll
                for (int k = 0; k < 4; ++k) { xo[128 * k] = x[k][0]; xo[128 * k + 1] = x[k][1]; }
            } else {
                float s2 = 0.f;
#pragma unroll
                for (int k = 0; k < 4; ++k)
#pragma unroll
                    for (int h = 0; h < 2; ++h) s2 += (x[k][h].x * x[k][h].x + x[k][h].y * x[k][h].y) + (x[k][h].z * x[k][h].z + x[k][h].w * x[k][h].w);
                const float r2 = 1.0f / sqrtf(wave_sum(s2) * (1.0f / DM) + EPS);
                if (lane == 0) R2[row] = r2;
                GAS v4u* xo = (GAS v4u*)(XB + (size_t)row * DM) + lane;
#pragma unroll
                for (int k = 0; k < 4; ++k) { v4u w; w.x = pk2(x[k][0].x, x[k][0].y); w.y = pk2(x[k][0].z, x[k][0].w); w.z = pk2(x[k][1].x, x[k][1].y); w.w = pk2(x[k][1].z, x[k][1].w); xo[64 * k] = w; }
            }
        }
    }
}

__device__ __forceinline__ void gmlp_unit(const bf16* Zc, bf16* CATc, int g, const float* wsg, const float* bsg, const float* vng, char* lds, const int wv) {
    using att::f32x16;
    const int tid = opaque_tid(wv), wid = tid >> 6, lane = tid & 63, r32 = lane & 31, hi = lane >> 5;
    bf16* vT = (bf16*)lds; float* mx = (float*)(lds + 36864);
    const int row = tid >> 2, cq = (tid & 3) * 8;
    {
        const bf16* vp = Zc + (size_t)row * AB_IN + 1024 + g * 128 + cq;
        float v[32]; float ss = 0.f;
#pragma unroll
        for (int i = 0; i < 4; ++i) { const v4u w = *(const v4u*)(vp + 32 * i);
            v[8 * i + 0] = bflo(w.x); v[8 * i + 1] = bfhi(w.x); v[8 * i + 2] = bflo(w.y); v[8 * i + 3] = bfhi(w.y); v[8 * i + 4] = bflo(w.z); v[8 * i + 5] = bfhi(w.z); v[8 * i + 6] = bflo(w.w); v[8 * i + 7] = bfhi(w.w); }
#pragma unroll
        for (int i = 0; i < 32; ++i) ss += v[i] * v[i];
        ss = xor_add<1>(ss); ss = xor_add<2>(ss);
        const float rn = 1.0f / sqrtf(ss * (1.0f / 128.0f) + EPS);
        const int qrot = (row + 16 * (tid & 3)) & 127;
#pragma unroll
        for (int i = 0; i < 4; ++i) { const f32x4 g0 = *(const f32x4*)(vng + 32 * i + cq), g1 = *(const f32x4*)(vng + 32 * i + cq + 4);
#pragma unroll
            for (int e2 = 0; e2 < 8; ++e2) vT[(32 * i + cq + e2) * 136 + qrot] = (bf16)f2bf(v[8 * i + e2] * rn * (e2 < 4 ? g0[e2 & 3] : g1[e2 & 3])); }
    }
    __syncthreads();
    const int pb = wid & 3, ch = wid >> 2;
    f32x16 acc[2] = {};
    const float* wrow = wsg + (32 * pb + r32) * 128 + 8 * hi;
    const int frot = 16 * ((r32 >> 3) & 3);
#pragma unroll
    for (int ks = 0; ks < 8; ++ks) {
        const f32x4 a0 = *(const f32x4*)(wrow + 16 * ks), a1 = *(const f32x4*)(wrow + 16 * ks + 4);
        v4u aw = {att::cvtpk(a0.x, a0.y), att::cvtpk(a0.z, a0.w), att::cvtpk(a1.x, a1.y), att::cvtpk(a1.z, a1.w)};
        const bf16x8 A = *reinterpret_cast<bf16x8*>(&aw);
#pragma unroll
        for (int cb = 0; cb < 2; ++cb) { const bf16x8 B = *(const bf16x8*)((const char*)vT + ((64 * ch + 32 * cb + r32) * 136 + ((16 * ks + 8 * hi + frot) & 127)) * 2);
            acc[cb] = __builtin_amdgcn_mfma_f32_32x32x16_bf16(A, B, acc[cb], 0, 0, 0); }
    }
#pragma unroll
    for (int r = 0; r < 16; ++r) { const int p = 32 * pb + att::crow(r, hi); const float bias = bsg[p];
#pragma unroll
        for (int cb = 0; cb < 2; ++cb) mx[p * 132 + 64 * ch + 32 * cb + r32] = acc[cb][r] + bias; }
    __syncthreads();
    {
        const bf16* up = Zc + (size_t)row * AB_IN + g * 128 + cq; bf16* op = CATc + (size_t)row * DM + g * 128 + cq;
#pragma unroll
        for (int i = 0; i < 4; ++i) { const v4u w = *(const v4u*)(up + 32 * i);
            const f32x4 m0 = *(const f32x4*)(mx + row * 132 + 32 * i + cq), m1 = *(const f32x4*)(mx + row * 132 + 32 * i + cq + 4);
            v4u o; o.x = pk2(bflo(w.x) * m0.x, bfhi(w.x) * m0.y); o.y = pk2(bflo(w.y) * m0.z, bfhi(w.y) * m0.w); o.z = pk2(bflo(w.z) * m1.x, bfhi(w.z) * m1.y); o.w = pk2(bflo(w.w) * m1.z, bfhi(w.w) * m1.w);
            *(v4u*)(op + 32 * i) = o; }
    }
    __syncthreads();
}

#define O_STAGE_STORE(VAL, stg, dst, ldd) do { \
    _Pragma("unroll") for (int r = 0; r < 16; ++r) { const int orow_ = att::crow(r, hi); \
        _Pragma("unroll") for (int d0 = 0; d0 < 4; ++d0) (stg)[orow_ * 136 + d0 * 32 + r32] = (bf16)f2bf(VAL(d0, r)); } \
    asm volatile("s_waitcnt lgkmcnt(0)" ::: "memory"); \
    _Pragma("unroll") for (int i_ = 0; i_ < 8; ++i_) { const int pi_ = i_ * 64 + lane, prow_ = pi_ >> 4, pch_ = pi_ & 15; \
        const v4u w_ = *(const v4u*)((stg) + prow_ * 136 + pch_ * 8); *(v4u*)((dst) + (long)prow_ * (ldd) + pch_ * 8) = w_; } \
    asm volatile("s_waitcnt lgkmcnt(0)" ::: "memory"); } while (0)

__device__ __forceinline__ void diff_attn_unit(const bf16* Zs, bf16* CATs, int S, int h, int qb, float lam, float oscale, const float* subg, char* lds, const int wv) {
    using namespace att;
    const int tid = opaque_tid(wv), wid = tid >> 6, lane = tid & 63, r32 = lane & 31, hi = lane >> 5, br = wid >> 2, wq = wid & 3;
    const long ld = AB_IN;
    const bf16* Qw = Zs + (long)(qb * 128 + wq * 32 + r32) * ld + 2048 + (br * 8 + h) * 64 + hi * 8;
    bf16x8 qr[4];
#pragma unroll
    for (int d0 = 0; d0 < 4; ++d0) qr[d0] = *(const bf16x8*)(Qw + d0 * 16);
    const int sr = tid >> 4, sc = (tid & 15) * 8;
    const unsigned offK = (unsigned)((sr * AB_IN + 3072 + h * 64 + (sc < 64 ? sc : 448 + sc)) * 2), offV = (unsigned)((sr * AB_IN + 4096 + h * 128 + sc) * 2);
    f32x16 o[4] = {}; float l = 0.f;
    attn_core_ring<4, false, true>(qr, (const char*)Zs, offK, offV, ld, S / 64, 0, br * 4, 0.f, l, o, lds, wv);
    float* li_l = (float*)(lds + RING_SCR) + wid * 64;
    if (hi == 0) li_l[r32] = l;
    asm volatile("s_waitcnt lgkmcnt(0)" ::: "memory");
    float rli[16];
#pragma unroll
    for (int r = 0; r < 16; ++r) rli[r] = __builtin_amdgcn_rcpf(li_l[crow(r, hi)]);
    __syncthreads();
    float* cbuf = (float*)lds + wq * 4096;
    if (br == 1) {
#pragma unroll
        for (int d0 = 0; d0 < 4; ++d0)
#pragma unroll
            for (int r = 0; r < 16; ++r) cbuf[(d0 * 16 + r) * 64 + lane] = o[d0][r] * rli[r];
    }
    __syncthreads();
    if (br == 0) {
        float g4[4];
#pragma unroll
        for (int d0 = 0; d0 < 4; ++d0) g4[d0] = subg[d0 * 32 + r32] * oscale;
        float rn[16];
#pragma unroll
        for (int r = 0; r < 16; ++r) {
            float ss = 0.f;
#pragma unroll
            for (int d0 = 0; d0 < 4; ++d0) { const float v = o[d0][r] * rli[r] - lam * cbuf[(d0 * 16 + r) * 64 + lane]; o[d0][r] = v; ss += v * v; }
            ss = xor_add<1>(ss); ss = xor_add<2>(ss); ss = xor_add<4>(ss); ss = xor_add<8>(ss); ss = xor_add<16>(ss);
            rn[r] = 1.0f / sqrtf(ss * (1.0f / 128.0f) + EPS);
        }
        asm volatile("s_waitcnt lgkmcnt(0)" ::: "memory");
        bf16* stg = (bf16*)cbuf; bf16* dst = CATs + (long)(qb * 128 + wq * 32) * DM + 1024 + h * 128;
#define DVAL(d0, r) (o[d0][r] * rn[r] * g4[d0])
        O_STAGE_STORE(DVAL, stg, dst, DM);
#undef DVAL
    }
    __syncthreads();
}

#ifndef WIN_SKIP
#define WIN_SKIP false
#endif
__device__ __forceinline__ void win_attn_unit(const bf16* Zs, bf16* CATs, int S, int hp, int qb, const float* sinks, char* lds, const int wv) {
    using namespace att;
    const int tid = opaque_tid(wv), wid = tid >> 6, lane = tid & 63, r32 = lane & 31, hi = lane >> 5;
    const long ld = C_INW; const int hq = 2 * hp + (wid >> 2), kvh = hp >> 1, q0 = qb * 128, qw = q0 + (wid & 3) * 32;
    const int klo = q0 - 128 < 0 ? 0 : q0 - 128, khi = q0 + 256 > S ? S : q0 + 256, NT = (khi - klo) / 64;
    const bf16* Qw = Zs + (long)(qw + r32) * ld + hq * 128 + hi * 8;
    bf16x8 qr[8];
#pragma unroll
    for (int d0 = 0; d0 < 8; ++d0) qr[d0] = *(const bf16x8*)(Qw + d0 * 16);
    const int sr = tid >> 4, sc = (tid & 15) * 8;
    const bf16* Kt = Zs + (long)(klo + sr) * ld + 2048 + kvh * 128 + sc;
    const bf16* Vt = Zs + (long)(klo + sr) * ld + 2560 + kvh * 128 + sc;
    f32x16 o[4] = {}; float l = 1.f;
    attn_core<8, true, 1, false, WIN_SKIP>(qr, Kt, Vt, ld, NT, klo - (qw + r32), 0, sinks[hq] * 1.4426950408889634f, l, o, lds, wv);
    float* li_l = (float*)(lds + SHM_SCR) + wid * 64;
    if (hi == 0) li_l[r32] = l;
    asm volatile("s_waitcnt lgkmcnt(0)" ::: "memory");
    float rl[16];
#pragma unroll
    for (int r = 0; r < 16; ++r) rl[r] = __builtin_amdgcn_rcpf(li_l[crow(r, hi)]);
    __syncthreads();
    { bf16* stg = (bf16*)(lds + wid * 8704); bf16* dst = CATs + (long)qw * DM + hq * 128;
#define WVAL(d0, r) (o[d0][r] * rl[r])
      O_STAGE_STORE(WVAL, stg, dst, DM);
#undef WVAL
    }
    __syncthreads();
}
#ifndef REP0
#define REP0 1
#endif
#ifndef REP1
#define REP1 1
#endif
#ifndef REP2
#define REP2 1
#endif
#ifndef REP3
#define REP3 1
#endif
#ifndef REP4
#define REP4 1
#endif
#ifndef REP5
#define REP5 1
#endif
#ifndef REP6
#define REP6 1
#endif
#ifndef REP7
#define REP7 1
#endif
#ifndef REP8
#define REP8 1
#endif
#ifndef REP9
#define REP9 1
#endif
#ifndef REP10
#define REP10 1
#endif
#ifndef PHASE_MASK
#define PHASE_MASK 0xFFFF
#endif
#ifndef MK_SPLIT
#define MK_SPLIT 0
#endif
constexpr int N_PHASES = 1 + 2 * (1 + 4 * 7);
__global__ void __launch_bounds__(NWAVES * 64, 2) fwd_kernel(Args a) {
    extern __shared__ __attribute__((aligned(16))) unsigned char lds[];
    LAS unsigned char* L = (LAS unsigned char*)lds;
    const int tid = threadIdx.x, wave = __builtin_amdgcn_readfirstlane(tid >> 6);
    const int G = gridDim.x, c = blockIdx.x;
    volatile LAS unsigned* MISC = (volatile LAS unsigned*)(L + MISC_OFF);
    for (int u = tid; u < (LDS_BYTES - RING_BYTES) / 4; u += NWAVES * 64) ((LAS unsigned*)(L + RING_BYTES))[u] = 0u;
    __syncthreads();
    unsigned char* ws0 = a.ws;
#define KARG ({ const __attribute__((address_space(4))) Args* p_ = (const __attribute__((address_space(4))) Args*)__builtin_amdgcn_kernarg_segment_ptr(); asm volatile("" : "+s"(p_)); p_; })
#define ws ({ GAS unsigned char* w_ = (GAS unsigned char*)ws0; asm volatile("" : "+s"(w_)); (unsigned char*)w_; })
#define AIN(k) ((const float*)(const GAS float*)KARG->in[k])
    unsigned* ctl = (unsigned*)(ws0 + WS_CTL);
    XcdBarrier bar = xcd_barrier_post(ctl + CW_BAR, MISC + 8);
#define IN() true
#define SEAM() xcd_barrier(bar)
    const int gw = c * NWAVES + wave, NGW = G * NWAVES;
    const bool x8 = (G & 7) == 0; const int xcd = c & 7, xr = c >> 3, xper = G >> 3;
#define H ((bf16*)(ws + WS_H))
#define R2 ((float*)(ws + WS_R2))
#define Z ((bf16*)(ws + WS_Z))
#define CAT ((bf16*)(ws + WS_CAT))
#define HID ((bf16*)(ws + WS_HID))
#define OUT ((bf16*)(ws + WS_OUT))
#define tabB ((const float*)(ws + WS_TABB))
#define tabC ((const float*)(ws + WS_TABC))
#define misc ((const float*)(ws + WS_MISC))

    if (IN() && ((PHASE_MASK >> 0) & 1)) { for (int rep_ = 0; rep_ < REP0; ++rep_) { prologue(a, L, gw, NGW, (opaque_tid(wave) & 63), wave); } SEAM(); }

    for (int grp = 0; grp < 2; ++grp) {
        const int S = grp ? 16384 : 2048, smask = S - 1;
        if (IN() && ((PHASE_MASK >> 1) & 1)) { for (int rep_ = 0; rep_ < REP1; ++rep_) { rowpass<0, 2>(AIN(grp), nullptr, H, nullptr, nullptr, R2, gw, NGW, (opaque_tid(wave) & 63)); } SEAM(); }
        for (int l = 0; l < DEPTH; ++l) {
            const int j = l >> 1;
            if ((l & 1) == 0) {
                if (IN() && ((PHASE_MASK >> 2) & 1)) { for (int rep_ = 0; rep_ < REP2; ++rep_) {
                    pg8::Gemm g{H, (const bf16*)(ws + WS_WINAB) + (size_t)j * AB_IN * DM, NTOK, AB_IN, DM}; pg8::StaticOrder So; So.init(NTOK, AB_IN, G, c, 8);
                    pg8::EpiAct<2> E{Z, AB_IN, tabB, smask, R2};
                    pg8::gemm_phase<pg8::EpiAct<2>, pg8::StaticOrder, true, true>(L, g, So, E, wave);
                    } SEAM(); }
                if (IN() && ((PHASE_MASK >> 3) & 1)) { for (int rep_ = 0; rep_ < REP3; ++rep_) {
                    if ((PHASE_MASK >> 11) & 1) { const int U = (NTOK / 128) * 8; const int u0 = x8 ? xcd * (U / 8) + xr : c, u1 = x8 ? (xcd + 1) * (U / 8) : U, us = x8 ? xper : G;
                      for (int u = u0; u < u1; u += us) { const int chunk = u >> 3, g = u & 7;
                          gmlp_unit(Z + (size_t)chunk * 128 * AB_IN, CAT + (size_t)chunk * 128 * DM, g, AIN(9) + (size_t)(j * 8 + g) * 16384, AIN(10) + (j * 8 + g) * 128, AIN(8) + (j * 8 + g) * 128, (char*)lds, wave); } }
                    if ((PHASE_MASK >> 12) & 1) { const float lam = misc[j], osc = misc[2 + j]; const float* subg = AIN(12) + j * 128;
                      const int nqb = S / 128, U = (NTOK / 128) * 8; const int u0 = x8 ? xcd * (U / 8) + xr : c, u1 = x8 ? (xcd + 1) * (U / 8) : U, us = x8 ? xper : G;
                      for (int u = u0; u < u1; u += us) { const int pair = u / nqb, qb = u % nqb, b = pair >> 3, h = pair & 7;
                          diff_attn_unit(Z + (size_t)b * S * AB_IN, CAT + (size_t)b * S * DM, S, h, qb, lam, osc, subg, (char*)lds, wave); } }
                    } SEAM(); }
            } else {
                if (IN() && ((PHASE_MASK >> 4) & 1)) { for (int rep_ = 0; rep_ < REP4; ++rep_) {
                    pg8::Gemm g{H, (const bf16*)(ws + WS_WINC) + (size_t)j * C_INW * DM, NTOK, C_INW, DM}; pg8::StaticOrder So; So.init(NTOK, C_INW, G, c, 8);
                    pg8::EpiAct<3> E{Z, C_INW, tabC, smask, R2};
                    pg8::gemm_phase<pg8::EpiAct<3>, pg8::StaticOrder, true, true>(L, g, So, E, wave);
                    } SEAM(); }
                if (IN() && ((PHASE_MASK >> 5) & 1)) { for (int rep_ = 0; rep_ < REP5; ++rep_) {
                    const int nqb = S / 128, U = (NTOK / 128) * 8; const int u0 = x8 ? xcd * (U / 8) + xr : c, u1 = x8 ? (xcd + 1) * (U / 8) : U, us = x8 ? xper : G;
                    for (int u = u0; u < u1; u += us) { const int blk = u >> 3, hp = u & 7, b = blk / nqb, qb = blk % nqb;
                        win_attn_unit(Z + (size_t)b * S * C_INW, CAT + (size_t)b * S * DM, S, hp, qb, AIN(15) + j * 16, (char*)lds, wave); }
                    } SEAM(); }
            }
            if (IN() && ((PHASE_MASK >> 6) & 1)) { for (int rep_ = 0; rep_ < REP6; ++rep_) {
                const bf16* Wt = (l & 1) ? (const bf16*)(ws + WS_WOUTC) + (size_t)j * DM * DM : (const bf16*)(ws + WS_WOUTAB) + (size_t)j * DM * DM;
                pg8::Gemm g{CAT, Wt, NTOK, DM, DM}; pg8::StaticOrder So; So.init(NTOK, DM, G, c, 8);
                pg8::EpiAct<0> E{OUT, DM, nullptr, 0, nullptr};
                pg8::gemm_phase<pg8::EpiAct<0>, pg8::StaticOrder, true, true>(L, g, So, E, wave);
                } SEAM(); }
            if (IN() && ((PHASE_MASK >> 7) & 1)) { for (int rep_ = 0; rep_ < REP7; ++rep_) { rowpass<1, 4>(nullptr, nullptr, H, OUT, AIN(3) + l * DM, R2, gw, NGW, (opaque_tid(wave) & 63)); } SEAM(); }
            if (IN() && ((PHASE_MASK >> 8) & 1)) { for (int rep_ = 0; rep_ < REP8; ++rep_) {
                pg8::Gemm g{H, (const bf16*)(ws + WS_WUP) + (size_t)l * DFF * DM, NTOK, DFF, DM}; pg8::StaticOrder So; So.init(NTOK, DFF, G, c);
                pg8::EpiAct<1> E{HID, DFF, nullptr, 0, R2};
                pg8::gemm_phase<pg8::EpiAct<1>, pg8::StaticOrder, true, true>(L, g, So, E, wave);
                } SEAM(); }
            if (IN() && ((PHASE_MASK >> 9) & 1)) { for (int rep_ = 0; rep_ < REP9; ++rep_) {
                pg8::Gemm g{HID, (const bf16*)(ws + WS_WDOWN) + (size_t)l * DM * DFF, NTOK, DM, DFF}; pg8::StaticOrder So; So.init(NTOK, DM, G, c);
                pg8::EpiAct<0> E{OUT, DM, nullptr, 0, nullptr};
                pg8::gemm_phase<pg8::EpiAct<0>, pg8::StaticOrder, true, true>(L, g, So, E, wave);
                } SEAM(); }
            if (IN() && ((PHASE_MASK >> 10) & 1)) { for (int rep_ = 0; rep_ < REP10; ++rep_) { if (l + 1 < DEPTH) rowpass<1, 4>(nullptr, nullptr, H, OUT, AIN(5) + l * DM, R2, gw, NGW, (opaque_tid(wave) & 63)); else rowpass<2, 4>(nullptr, ((float*)(GAS float*)KARG->out) + (size_t)grp * NTOK * DM, H, OUT, AIN(5) + l * DM, nullptr, gw, NGW, (opaque_tid(wave) & 63)); } if (!(grp == 1 && l + 1 == DEPTH)) SEAM(); }
        }
    }
#undef IN
#undef SEAM
#undef ws
#undef KARG
#undef AIN
#undef H
#undef R2
#undef Z
#undef CAT
#undef HID
#undef OUT
#undef tabB
#undef tabC
#undef misc
}

extern "C" void kernel_launch(void* const* d_in, const int* in_sizes, int n_in, void* d_out, int out_size, void* d_ws, size_t ws_size, hipStream_t stream) {
    static int grid = 0;
    if (grid == 0) {
        if (n_in != 18 || in_sizes[0] != NTOK * DM || in_sizes[1] != NTOK * DM || out_size != 2 * NTOK * DM || ws_size < WS_END) {
            fprintf(stderr, "kernel_launch: unexpected shapes (n_in %d, in0 %d, out %d, ws %zu, need ws >= %zu); nothing launched\n", n_in, n_in > 0 ? in_sizes[0] : -1, out_size, ws_size, (size_t)WS_END); grid = -1; return; }
        int dev = 0, cus = 0;
        if (hipGetDevice(&dev) != hipSuccess || hipDeviceGetAttribute(&cus, hipDeviceAttributeMultiprocessorCount, dev) != hipSuccess) { grid = -1; return; }
        if (hipFuncSetAttribute((const void*)fwd_kernel, hipFuncAttributeMaxDynamicSharedMemorySize, LDS_BYTES) != hipSuccess) { fprintf(stderr, "kernel_launch: hipFuncSetAttribute failed\n"); grid = -1; return; }
        int per_cu = 0;
        if (hipOccupancyMaxActiveBlocksPerMultiprocessor(&per_cu, (const void*)fwd_kernel, NWAVES * 64, LDS_BYTES) != hipSuccess || per_cu < 1) { fprintf(stderr, "kernel_launch: occupancy query says %d blocks per CU\n", per_cu); }
        (void)hipGetLastError();
        grid = cus;
    }
    if (grid < 0) return;
    if (hipMemsetAsync((char*)d_ws + WS_CTL, 0, CTL_ZERO_BYTES, stream) != hipSuccess) return;
    Args a{};
    for (int i = 0; i < 18; ++i) a.in[i] = (const float*)d_in[i];
    a.out = (float*)d_out; a.ws = (unsigned char*)d_ws;
    a.ph_lo = 0; a.ph_hi = N_PHASES;
    hipLaunchKernelGGL(fwd_kernel, dim3(grid), dim3(NWAVES * 64), LDS_BYTES, stream, a);
    const hipError_t le = hipPeekAtLastError();
    if (le != hipSuccess) fprintf(stderr, "kernel_launch: launch failed: %s\n", hipGetErrorName(le));
}
```
